# Optimizing an MI355X kernel written in HIP

```python
import jax
import jax.numpy as jnp
from jax import lax
import numpy as np

D_MODEL = 1024
BATCH = 8
SEQ = 4096
DEPTH = 4

N_META = 16
EXPAND = 2
D_INNER = EXPAND * D_MODEL
BLOCK = 128
ROPE_THETA = 10000.0
EPS = 1e-6
NEG_INF = -1e30

MLA_HEADS = 8
MLA_Q_RANK = 384
MLA_KV_RANK = 256
MLA_NOPE = 128
MLA_ROPE = 64
MLA_QK = MLA_NOPE + MLA_ROPE
MLA_V = 128
MLA_WIDTH = MLA_HEADS * MLA_V

SWA_HEADS = 8
SWA_KV_HEADS = 2
SWA_REP = SWA_HEADS // SWA_KV_HEADS
SWA_HEAD_DIM = 128
SWA_WINDOW = 128
SWA_WIDTH = SWA_HEADS * SWA_HEAD_DIM
SWA_KV_WIDTH = SWA_KV_HEADS * SWA_HEAD_DIM

LRU_WIDTH = D_INNER
LRU_BLOCKS = 16
LRU_BLOCK_DIM = LRU_WIDTH // LRU_BLOCKS
LRU_C = 8.0
CONV_WIDTH = 4
CONV_PAD_LEFT = 2
CONV_PAD_RIGHT = 1

EVEN_SPLITS = (MLA_Q_RANK, MLA_KV_RANK, MLA_ROPE, SWA_WIDTH, SWA_KV_WIDTH, SWA_KV_WIDTH, D_INNER)
EVEN_IN = MLA_Q_RANK + MLA_KV_RANK + MLA_ROPE + SWA_WIDTH + 2 * SWA_KV_WIDTH + D_INNER
ODD_SPLITS = (LRU_WIDTH, D_INNER)
ODD_IN = LRU_WIDTH + D_INNER
N_EVEN = (DEPTH + 1) // 2
N_ODD = DEPTH // 2

kernel_name = "hybrid_mla_swa_rglru_encoder"


def rms_norm(x, g):
    xf = x.astype(jnp.float32)
    y = xf * lax.rsqrt(jnp.mean(xf * xf, axis=-1, keepdims=True) + EPS)
    return (y * g.astype(jnp.float32)).astype(x.dtype)


def rope_tables(T, dim):
    inv = ROPE_THETA ** (-jnp.arange(0, dim, 2, dtype=jnp.float32) / dim)
    ang = jnp.arange(T, dtype=jnp.float32)[:, None] * inv[None, :]
    return jnp.cos(ang), jnp.sin(ang)


def apply_rope(x, cos, sin):
    x1, x2 = jnp.split(x, 2, axis=-1)
    c = cos.astype(x.dtype)
    s = sin.astype(x.dtype)
    return jnp.concatenate([x1 * c - x2 * s, x1 * s + x2 * c], axis=-1)


def split_cols(z, sizes):
    out = []
    start = 0
    for s in sizes:
        out.append(z[..., start:start + s])
        start += s
    return out


def blocked_dense_attention(q, k, v, scale):
    B, H, T, dq = q.shape
    dv = v.shape[-1]
    nb = (T - N_META) // BLOCK

    def attend(qb):
        s = jnp.einsum('bhqd,bhkd->bhqk', qb, k, preferred_element_type=jnp.float32) * scale
        p = jax.nn.softmax(s, axis=-1).astype(v.dtype)
        return jnp.einsum('bhqk,bhkd->bhqd', p, v)

    o_meta = attend(q[:, :, :N_META])
    qb = q[:, :, N_META:].reshape(B, H, nb, BLOCK, dq).transpose(2, 0, 1, 3, 4)
    o_real = lax.map(attend, qb).transpose(1, 2, 0, 3, 4).reshape(B, H, nb * BLOCK, dv)
    return jnp.concatenate([o_meta, o_real], axis=2)


def banded_window_attention(q, k, v, sink, scale):
    B, G, R, T, d = q.shape
    L = T - N_META
    nb = L // BLOCK
    k_m, v_m = k[:, :, :N_META], v[:, :, :N_META]
    k_r, v_r = k[:, :, N_META:], v[:, :, N_META:]
    sink_l = sink.astype(jnp.float32).reshape(G, R)

    def band(t):
        tp = jnp.pad(t, ((0, 0), (0, 0), (BLOCK, BLOCK), (0, 0))).reshape(B, G, nb + 2, BLOCK, d)
        return jnp.concatenate([tp[:, :, :-2], tp[:, :, 1:-1], tp[:, :, 2:]], axis=3)

    k_b, v_b = band(k_r), band(v_r)
    q_b = q[:, :, :, N_META:].reshape(B, G, R, nb, BLOCK, d)
    blk = jnp.arange(nb)[:, None, None]
    qpos = blk * BLOCK + jnp.arange(BLOCK)[None, :, None]
    kpos = blk * BLOCK - BLOCK + jnp.arange(3 * BLOCK)[None, None, :]
    valid = (jnp.abs(qpos - kpos) <= SWA_WINDOW) & (kpos >= 0) & (kpos < L)
    s_meta = jnp.einsum('bgrnqd,bgmd->bgrnqm', q_b, k_m, preferred_element_type=jnp.float32) * scale
    s_band = jnp.einsum('bgrnqd,bgnkd->bgrnqk', q_b, k_b, preferred_element_type=jnp.float32) * scale
    s_band = jnp.where(valid, s_band, NEG_INF)
    s_sink = jnp.broadcast_to(sink_l[None, :, :, None, None, None], (B, G, R, nb, BLOCK, 1))
    p = jax.nn.softmax(jnp.concatenate([s_sink, s_meta, s_band], axis=-1), axis=-1).astype(v.dtype)
    o_real = (jnp.einsum('bgrnqm,bgmd->bgrnqd', p[..., 1:1 + N_META], v_m)
              + jnp.einsum('bgrnqk,bgnkd->bgrnqd', p[..., 1 + N_META:], v_b))
    o_real = o_real.reshape(B, G, R, L, d)

    q_m = q[:, :, :, :N_META]
    k_f, v_f = k_r[:, :, :BLOCK], v_r[:, :, :BLOCK]
    valid_m = (N_META + jnp.arange(BLOCK)[None, :] - jnp.arange(N_META)[:, None]) <= SWA_WINDOW
    s_mm = jnp.einsum('bgrqd,bgmd->bgrqm', q_m, k_m, preferred_element_type=jnp.float32) * scale
    s_mf = jnp.einsum('bgrqd,bgkd->bgrqk', q_m, k_f, preferred_element_type=jnp.float32) * scale
    s_mf = jnp.where(valid_m, s_mf, NEG_INF)
    s_ms = jnp.broadcast_to(sink_l[None, :, :, None, None], (B, G, R, N_META, 1))
    p_m = jax.nn.softmax(jnp.concatenate([s_ms, s_mm, s_mf], axis=-1), axis=-1).astype(v.dtype)
    o_meta = (jnp.einsum('bgrqm,bgmd->bgrqd', p_m[..., 1:1 + N_META], v_m)
              + jnp.einsum('bgrqk,bgkd->bgrqd', p_m[..., 1 + N_META:], v_f))
    return jnp.concatenate([o_meta, o_real], axis=3)


def mla_mixer(c_q, c_kv, k_pe, g_q_lat, g_kv_lat, w_uq, w_ukv, g_qn, g_kn, cos, sin):
    B, T, _ = c_q.shape
    q = jnp.einsum('btr,rhd->bhtd', rms_norm(c_q, g_q_lat), w_uq)
    kv = jnp.einsum('btr,rhd->bhtd', rms_norm(c_kv, g_kv_lat), w_ukv)
    k_nope, v = kv[..., :MLA_NOPE], kv[..., MLA_NOPE:]
    k_pe = jnp.broadcast_to(k_pe[:, None], (B, MLA_HEADS, T, MLA_ROPE))
    k = jnp.concatenate([k_nope, k_pe], axis=-1)
    q = rms_norm(q, g_qn)
    k = rms_norm(k, g_kn)
    q = jnp.concatenate([q[..., :MLA_NOPE], apply_rope(q[..., MLA_NOPE:], cos, sin)], axis=-1)
    k = jnp.concatenate([k[..., :MLA_NOPE], apply_rope(k[..., MLA_NOPE:], cos, sin)], axis=-1)
    o = blocked_dense_attention(q, k, v, MLA_QK ** -0.5)
    return o.transpose(0, 2, 1, 3).reshape(B, T, MLA_WIDTH)


def swa_mixer(q_s, k_s, v_s, g_qn, g_kn, sink, cos, sin):
    B, T, _ = q_s.shape
    q = q_s.reshape(B, T, SWA_HEADS, SWA_HEAD_DIM).transpose(0, 2, 1, 3)
    k = k_s.reshape(B, T, SWA_KV_HEADS, SWA_HEAD_DIM).transpose(0, 2, 1, 3)
    v = v_s.reshape(B, T, SWA_KV_HEADS, SWA_HEAD_DIM).transpose(0, 2, 1, 3)
    q = apply_rope(rms_norm(q, g_qn), cos, sin)
    k = apply_rope(rms_norm(k, g_kn), cos, sin)
    q = q.reshape(B, SWA_KV_HEADS, SWA_REP, T, SWA_HEAD_DIM)
    o = banded_window_attention(q, k, v, sink, SWA_HEAD_DIM ** -0.5)
    return o.reshape(B, SWA_HEADS, T, SWA_HEAD_DIM).transpose(0, 2, 1, 3).reshape(B, T, SWA_WIDTH)


def even_layer(z, w_in, g_q_lat, g_kv_lat, w_uq, w_ukv, mla_g_qn, mla_g_kn,
               swa_g_qn, swa_g_kn, sink, w_out, rope_mla, rope_swa):
    zp = jnp.einsum('btd,de->bte', z, w_in)
    c_q, c_kv, k_pe, q_s, k_s, v_s, gate = split_cols(zp, EVEN_SPLITS)
    y_a = mla_mixer(c_q, c_kv, k_pe, g_q_lat, g_kv_lat, w_uq, w_ukv,
                    mla_g_qn, mla_g_kn, rope_mla[0], rope_mla[1])
    y_b = swa_mixer(q_s, k_s, v_s, swa_g_qn, swa_g_kn, sink, rope_swa[0], rope_swa[1])
    y = jnp.concatenate([y_a, y_b], axis=-1) * jax.nn.silu(gate)
    return jnp.einsum('bte,ed->btd', y, w_out)


def lru_direction(xc, w_a, b_a, w_x, b_x, lam, reverse):
    B, T, W = xc.shape
    xb = xc.reshape(B, T, LRU_BLOCKS, LRU_BLOCK_DIM)
    r = jax.nn.sigmoid((jnp.einsum('btnd,nde->btne', xb, w_a).reshape(B, T, W) + b_a).astype(jnp.float32))
    i = jax.nn.sigmoid((jnp.einsum('btnd,nde->btne', xb, w_x).reshape(B, T, W) + b_x).astype(jnp.float32))
    log_a = -LRU_C * r * jax.nn.softplus(-lam.astype(jnp.float32))
    a = jnp.exp(log_a)
    b = jnp.sqrt(-jnp.expm1(2.0 * log_a)) * i * xc.astype(jnp.float32)

    def step(h, ab):
        a_t, b_t = ab
        h = a_t * h + b_t
        return h, h

    _, hs = lax.scan(step, jnp.zeros((B, W), jnp.float32),
                     (a.swapaxes(0, 1), b.swapaxes(0, 1)), reverse=reverse)
    return hs.swapaxes(0, 1).astype(xc.dtype)


def odd_layer(z, w_in, conv_w, conv_b, w_a, b_a, w_x, b_x, lam, w_out):
    zp = jnp.einsum('btd,de->bte', z, w_in)
    u, gate = split_cols(zp, ODD_SPLITS)
    T = u.shape[1]
    up = jnp.pad(u, ((0, 0), (CONV_PAD_LEFT, CONV_PAD_RIGHT), (0, 0)))
    xc = conv_b
    for tap in range(CONV_WIDTH):
        xc = xc + up[:, tap:tap + T] * conv_w[tap]
    y = (lru_direction(xc, w_a[0], b_a[0], w_x[0], b_x[0], lam[0], reverse=False)
         + lru_direction(xc, w_a[1], b_a[1], w_x[1], b_x[1], lam[1], reverse=True))
    y = y * jax.nn.silu(gate)
    return jnp.einsum('bte,ed->btd', y, w_out)


def setup_inputs(seed: int = 0) -> dict:
    key = jax.random.key(seed)
    ks = jax.random.split(key, 24)
    f32 = jnp.float32

    def nrm(k, shape, scale):
        return jax.random.normal(k, shape, f32) * scale

    def gain(k, shape):
        return 1.0 + 0.01 * jax.random.normal(k, shape, f32)

    u = jax.random.uniform(ks[23], (N_ODD, 2, LRU_WIDTH), f32, 0.9, 0.999)
    a0 = u ** (1.0 / LRU_C)
    lru_lambda = jnp.log(a0) - jnp.log1p(-a0)

    return {
        "x": nrm(ks[0], (BATCH, SEQ, D_MODEL), 1.0),
        "meta_tokens": nrm(ks[1], (N_META, D_MODEL), 1.0),
        "norm_g": gain(ks[2], (DEPTH, D_MODEL)),
        "even_w_in": nrm(ks[3], (N_EVEN, D_MODEL, EVEN_IN), D_MODEL ** -0.5),
        "mla_g_q_lat": gain(ks[4], (N_EVEN, MLA_Q_RANK)),
        "mla_g_kv_lat": gain(ks[5], (N_EVEN, MLA_KV_RANK)),
        "mla_w_uq": nrm(ks[6], (N_EVEN, MLA_Q_RANK, MLA_HEADS, MLA_QK), MLA_Q_RANK ** -0.5),
        "mla_w_ukv": nrm(ks[7], (N_EVEN, MLA_KV_RANK, MLA_HEADS, MLA_NOPE + MLA_V), MLA_KV_RANK ** -0.5),
        "mla_g_qn": gain(ks[8], (N_EVEN, MLA_QK)),
        "mla_g_kn": gain(ks[9], (N_EVEN, MLA_QK)),
        "swa_g_qn": gain(ks[10], (N_EVEN, SWA_HEAD_DIM)),
        "swa_g_kn": gain(ks[11], (N_EVEN, SWA_HEAD_DIM)),
        "swa_sink": nrm(ks[12], (N_EVEN, SWA_HEADS), 0.5),
        "even_w_out": nrm(ks[13], (N_EVEN, D_INNER, D_MODEL), D_INNER ** -0.5),
        "odd_w_in": nrm(ks[14], (N_ODD, D_MODEL, ODD_IN), D_MODEL ** -0.5),
        "lru_conv_w": nrm(ks[15], (N_ODD, CONV_WIDTH, LRU_WIDTH), CONV_WIDTH ** -0.5),
        "lru_conv_b": nrm(ks[16], (N_ODD, LRU_WIDTH), 0.01),
        "lru_w_a": nrm(ks[17], (N_ODD, 2, LRU_BLOCKS, LRU_BLOCK_DIM, LRU_BLOCK_DIM), LRU_BLOCK_DIM ** -0.5),
        "lru_b_a": nrm(ks[18], (N_ODD, 2, LRU_WIDTH), 0.01),
        "lru_w_x": nrm(ks[19], (N_ODD, 2, LRU_BLOCKS, LRU_BLOCK_DIM, LRU_BLOCK_DIM), LRU_BLOCK_DIM ** -0.5),
        "lru_b_x": nrm(ks[20], (N_ODD, 2, LRU_WIDTH), 0.01),
        "lru_lambda": lru_lambda,
        "odd_w_out": nrm(ks[21], (N_ODD, D_INNER, D_MODEL), D_INNER ** -0.5),
    }


def reference(x, meta_tokens, norm_g, even_w_in, mla_g_q_lat, mla_g_kv_lat, mla_w_uq, mla_w_ukv,
              mla_g_qn, mla_g_kn, swa_g_qn, swa_g_kn, swa_sink, even_w_out,
              odd_w_in, lru_conv_w, lru_conv_b, lru_w_a, lru_b_a, lru_w_x, lru_b_x,
              lru_lambda, odd_w_out):
    B = x.shape[0]
    meta = jnp.broadcast_to(meta_tokens.astype(x.dtype)[None], (B, N_META, D_MODEL))
    h = jnp.concatenate([meta, x], axis=1)
    T = h.shape[1]
    rope_mla = rope_tables(T, MLA_ROPE)
    rope_swa = rope_tables(T, SWA_HEAD_DIM)
    for l in range(DEPTH):
        z = rms_norm(h, norm_g[l])
        j = l // 2
        if l % 2 == 0:
            y = even_layer(z, even_w_in[j], mla_g_q_lat[j], mla_g_kv_lat[j], mla_w_uq[j], mla_w_ukv[j],
                           mla_g_qn[j], mla_g_kn[j], swa_g_qn[j], swa_g_kn[j], swa_sink[j],
                           even_w_out[j], rope_mla, rope_swa)
        else:
            y = odd_layer(z, odd_w_in[j], lru_conv_w[j], lru_conv_b[j], lru_w_a[j], lru_b_a[j],
                          lru_w_x[j], lru_b_x[j], lru_lambda[j], odd_w_out[j])
        h = h + y
    return h[:, N_META:]
```

```cpp
#include <hip/hip_runtime.h>
#include <hip/hip_cooperative_groups.h>
#include <cstdio>
#include <cstdint>
namespace cg = cooperative_groups;

constexpr int NBATCH = 8, SEQ = 4096, NMETA = 16, T = SEQ + NMETA, DM = 1024, DI = 2048;
constexpr int GB = 4, NG = NBATCH / GB, R = GB * T, RP = ((R + 255) / 256) * 256;
constexpr int EIN = 4288, EINP = 4352, OIN = 4096;
constexpr int C_CQ = 0, C_CKV = 384, C_KPE = 640, C_QS = 704, C_KS = 1728, C_VS = 1984, C_GATE = 2240;
constexpr float EPS = 1e-6f;
constexpr int NCH = 64;
constexpr int NWAVES = 8, NTHR = 512;
constexpr int LDS_BYTES = 139264;

constexpr size_t al256(size_t x) { return (x + 255) / 256 * 256; }
constexpr size_t WS_WINE = 0;
constexpr size_t WS_WUQ = WS_WINE + (size_t)2 * EINP * DM * 2;
constexpr size_t WS_WUKV = WS_WUQ + (size_t)2 * 1536 * 384 * 2;
constexpr size_t WS_WOUTE = WS_WUKV + (size_t)2 * 2048 * 256 * 2;
constexpr size_t WS_WINO = WS_WOUTE + (size_t)2 * DM * DI * 2;
constexpr size_t WS_WOUTO = WS_WINO + (size_t)2 * OIN * DM * 2;
constexpr size_t WS_WG = WS_WOUTO + (size_t)2 * DM * DI * 2;
constexpr size_t WS_HMETA = WS_WG + (size_t)2 * 2 * 16 * 256 * 128 * 2;
constexpr size_t WS_CARP = WS_HMETA + (size_t)NBATCH * NMETA * DM * 4;
constexpr size_t WS_CARH = WS_CARP + (size_t)GB * NCH * DI * 4;
constexpr size_t WS_SP = WS_CARH + (size_t)GB * NCH * DI * 4;
constexpr size_t WS_BAR = WS_SP + (size_t)4 * DI * 4;
constexpr size_t WS_ACT = (size_t)64 << 20;
static_assert(WS_BAR + 16384 <= WS_ACT, "weights region");
constexpr size_t A_Z = WS_ACT;
constexpr size_t A_ZP = A_Z + (size_t)RP * DM * 2;
constexpr size_t A_CQN = A_ZP + (size_t)RP * EINP * 2;
constexpr size_t A_CKVN = A_CQN + (size_t)RP * 384 * 2;
constexpr size_t A_Q = A_CKVN + (size_t)RP * 256 * 2;
constexpr size_t A_K = A_Q + (size_t)RP * 1536 * 2;
constexpr size_t A_V = A_K + (size_t)RP * 1536 * 2;
constexpr size_t A_END_E = A_V + (size_t)RP * 1024 * 2;
constexpr size_t A_XC = A_ZP + (size_t)RP * OIN * 2;
constexpr size_t A_LA = A_XC + (size_t)RP * DI * 2;
constexpr size_t A_BB = A_LA + (size_t)RP * DI * 2;
constexpr size_t A_END_O = A_BB + (size_t)RP * DI * 2;
constexpr size_t WS_NEED = A_END_E > A_END_O ? A_END_E : A_END_O;
static_assert(WS_NEED <= ((size_t)512 << 20), "workspace budget");

struct Params { const float* in[23]; float* out; unsigned char* ws; };
typedef const Params __attribute__((address_space(4)))* KP;

typedef unsigned short bf16_t;
typedef short bf16x8 __attribute__((ext_vector_type(8)));
typedef short s16x4 __attribute__((ext_vector_type(4)));
typedef float f32x4 __attribute__((ext_vector_type(4)));
typedef float f32x16 __attribute__((ext_vector_type(16)));
typedef unsigned u32x4 __attribute__((ext_vector_type(4)));
typedef unsigned u32x2 __attribute__((ext_vector_type(2)));
#define LAS __attribute__((address_space(3)))

__device__ __forceinline__ unsigned cvt_pk_bf16(float lo, float hi) { unsigned r; asm volatile("v_cvt_pk_bf16_f32 %0, %1, %2" : "=v"(r) : "v"(lo), "v"(hi)); return r; }
__device__ __forceinline__ float bf2f(unsigned short v) { return __uint_as_float((unsigned)v << 16); }
__device__ __forceinline__ float bflo(unsigned v) { return __uint_as_float(v << 16); }
__device__ __forceinline__ float bfhi(unsigned v) { return __uint_as_float(v & 0xffff0000u); }
__device__ __forceinline__ unsigned short f2bf(float f) { return (unsigned short)(cvt_pk_bf16(f, 0.f) & 0xffffu); }
typedef _Float16 h2_t __attribute__((ext_vector_type(2)));
__device__ __forceinline__ unsigned pk_h2(float a, float b) { h2_t v = {(_Float16)a, (_Float16)b}; return __builtin_bit_cast(unsigned, v); }
__device__ __forceinline__ float h2lo(unsigned u) { h2_t v = __builtin_bit_cast(h2_t, u); return (float)v[0]; }
__device__ __forceinline__ float h2hi(unsigned u) { h2_t v = __builtin_bit_cast(h2_t, u); return (float)v[1]; }
template <int CTRL> __device__ __forceinline__ float dppx(float v) { return __int_as_float(__builtin_amdgcn_update_dpp(0, __float_as_int(v), CTRL, 0xf, 0xf, false)); }
__device__ __forceinline__ float wave_sum(float v) {
    v += dppx<0xB1>(v); v += dppx<0x4E>(v); v += dppx<0x141>(v); v += dppx<0x140>(v);
    v += __int_as_float(__builtin_amdgcn_ds_swizzle(__float_as_int(v), 0x401F));
    auto rr = __builtin_amdgcn_permlane32_swap(__float_as_uint(v), __float_as_uint(v), false, false);
    return __uint_as_float(rr[0]) + __uint_as_float(rr[1]);
}
__device__ __forceinline__ int olane() { int l; asm volatile("v_mbcnt_lo_u32_b32 %0, -1, 0\n\tv_mbcnt_hi_u32_b32 %0, -1, %0" : "=v"(l)); return l; }
__device__ __forceinline__ int otid(int wv) { return wv * 64 + olane(); }
__device__ __forceinline__ int obid() { int b = blockIdx.x; asm volatile("" : "+s"(b)); return b; }
__device__ __forceinline__ float sigmoidf_(float x) { return __builtin_amdgcn_rcpf(1.f + __expf(-x)); }
__device__ __forceinline__ float siluf_(float x) { return x * __builtin_amdgcn_rcpf(1.f + __expf(-x)); }

__device__ __forceinline__ const float* h_src(KP p, int layer, int b, int t) {
    if (layer == 0) return t < NMETA ? p->in[1] + (size_t)t * DM : p->in[0] + ((size_t)b * SEQ + (t - NMETA)) * DM;
    return t < NMETA ? (const float*)(p->ws + WS_HMETA) + ((size_t)b * NMETA + t) * DM : p->out + ((size_t)b * SEQ + (t - NMETA)) * DM;
}
__device__ __forceinline__ float* h_dst(KP p, int b, int t) {
    return t < NMETA ? (float*)(p->ws + WS_HMETA) + ((size_t)b * NMETA + t) * DM : p->out + ((size_t)b * SEQ + (t - NMETA)) * DM;
}

namespace pg8 {
#define PG8_LAS __attribute__((address_space(3)))
typedef unsigned short bf16_t;
typedef short bf16x8 __attribute__((ext_vector_type(8)));
typedef float f32x4 __attribute__((ext_vector_type(4)));
typedef unsigned u32x4 __attribute__((ext_vector_type(4)));
constexpr int BM = 256, BK = 64, HALF = 128, HTB = HALF * BK * 2  , STAGE_BYTES = 8 * HTB, NXCD = 8, WGM = 8;

__host__ __device__ __forceinline__ int lds_byte(int r, int c) { const int st = (r >> 4) * 2 + (c >> 5), rr = r & 15, cc = c & 31, ob = rr * 64 + cc * 2; return st * 1024 + (ob ^ (((ob >> 9) & 1) << 5)); }
__host__ __device__ __forceinline__ void stage_rc(int b, int& R, int& C) { const int st = b / 1024, sb = b % 1024, swz = sb ^ (((sb >> 9) & 1) << 5); R = (st >> 1) * 16 + swz / 64; C = (st & 1) * 32 + (swz % 64) / 2; }
__host__ __device__ __forceinline__ int perm32(int rho) { const int n = rho >> 4, i = rho & 15; return 8 * (i >> 2) + 4 * n + (i & 3); }

struct Unit { int pm, pn; };
struct Gemm { const bf16_t* A; const bf16_t* Bt; };

struct StaticOrder {
    int nM, nN, nwg, G, c;
    __host__ __device__ void init(int M, int N, int G_, int c_) { nM = M / BM; nN = N / BM; nwg = nM * nN; G = G_; c = c_; }
    __host__ __device__ bool next(int i, Unit& u) const {
        const long L = (long)i * G + c; if (L >= nwg) return false;
        int wgid = (int)L; { const int q = nwg / NXCD, r = nwg % NXCD, xcd = wgid % NXCD, off = wgid / NXCD; wgid = (xcd < r ? xcd * (q + 1) : r * (q + 1) + (xcd - r) * q) + off; }
        const int nig = WGM * nN, gid = wgid / nig, fm = gid * WGM, gsz = (nM - fm) < WGM ? (nM - fm) : WGM;
        u.pm = fm + ((wgid % nig) % gsz); u.pn = (wgid % nig) / gsz; return true;
    }
    __device__ __forceinline__ void a_ready(const Unit&) const {}
    __device__ __forceinline__ void done(const Unit&) const {}
};
struct TailOrder {
    StaticOrder in; int nN, last;
    __host__ __device__ void init(int M, int N, int G_, int c_) { in.init(M - BM, N, G_, c_); nN = N / BM; last = M / BM - 1; }
    __host__ __device__ bool next(int i, Unit& u) const { if (in.next(i, u)) return true; const int L = i * in.G + in.c - in.nwg; if (L < nN) { u.pm = last; u.pn = L; return true; } return false; }
    __device__ __forceinline__ void a_ready(const Unit&) const {}
    __device__ __forceinline__ void done(const Unit&) const {}
};


struct EpiStore {
    static constexpr bool PERM = true, AFTER_DRAIN = false;
    bf16_t* O; int ldc;
    __device__ __forceinline__ void operator()(const f32x4 (&acc)[2][2][4][2], const Unit& u, int wr, int wc, int fr, int fq) const {
        const int row0 = u.pm * BM + wr * 64 + fr, col0 = u.pn * BM + wc * 32 + 8 * fq;
#pragma unroll
        for (int ai = 0; ai < 2; ++ai)
#pragma unroll
            for (int m = 0; m < 4; ++m) { bf16_t* rowp = O + (size_t)(row0 + ai * HALF + m * 16) * ldc + col0;
#pragma unroll
                for (int bj = 0; bj < 2; ++bj) { const f32x4 v0 = acc[ai][bj][m][0], v1 = acc[ai][bj][m][1];
                    u32x4 w; w.x = cvt_pk_bf16(v0[0], v0[1]); w.y = cvt_pk_bf16(v0[2], v0[3]); w.z = cvt_pk_bf16(v1[0], v1[1]); w.w = cvt_pk_bf16(v1[2], v1[3]);
                    *(u32x4*)(rowp + bj * HALF) = w; } }
    }
};
struct EpiKV {
    static constexpr bool PERM = true, AFTER_DRAIN = false;
    bf16_t* Kb; bf16_t* Vb;
    __device__ __forceinline__ void operator()(const f32x4 (&acc)[2][2][4][2], const Unit& u, int wr, int wc, int fr, int fq) const {
        const int row0 = u.pm * BM + wr * 64 + fr, d0 = wc * 32 + 8 * fq;
#pragma unroll
        for (int ai = 0; ai < 2; ++ai)
#pragma unroll
            for (int m = 0; m < 4; ++m) { const size_t row = (size_t)(row0 + ai * HALF + m * 16);
#pragma unroll
                for (int bj = 0; bj < 2; ++bj) { const f32x4 v0 = acc[ai][bj][m][0], v1 = acc[ai][bj][m][1];
                    u32x4 w; w.x = cvt_pk_bf16(v0[0], v0[1]); w.y = cvt_pk_bf16(v0[2], v0[3]); w.z = cvt_pk_bf16(v1[0], v1[1]); w.w = cvt_pk_bf16(v1[2], v1[3]);
                    bf16_t* dst = bj == 0 ? Kb + row * 1536 + u.pn * 192 + d0 : Vb + row * 1024 + u.pn * 128 + d0;
                    *(u32x4*)dst = w; } }
    }
};
struct EpiRes {
    static constexpr bool PERM = true, AFTER_DRAIN = false;
    const float* x; const float* meta; float* out; float* hmeta; int layer, g;
    __device__ __forceinline__ void operator()(const f32x4 (&acc)[2][2][4][2], const Unit& u, int wr, int wc, int fr, int fq) const {
        const int row0 = u.pm * BM + wr * 64 + fr, col0 = u.pn * BM + wc * 32 + 8 * fq;
#pragma unroll
        for (int ai = 0; ai < 2; ++ai)
#pragma unroll
            for (int m = 0; m < 4; ++m) { const int lr = row0 + ai * HALF + m * 16;
                if (lr < R) { const int bl = lr / T, t = lr - bl * T, b = g * GB + bl;
                    float* d; const float* s;
                    if (t < NMETA) { d = hmeta + ((size_t)b * NMETA + t) * DM; s = layer == 0 ? meta + (size_t)t * DM : d; }
                    else { const size_t o = ((size_t)b * SEQ + (t - NMETA)) * DM; d = out + o; s = layer == 0 ? x + o : d; }
#pragma unroll
                    for (int bj = 0; bj < 2; ++bj) { const int c = col0 + bj * HALF;
                        const f32x4 a0 = *(const f32x4*)(s + c), a1 = *(const f32x4*)(s + c + 4);
                        *(f32x4*)(d + c) = a0 + acc[ai][bj][m][0]; *(f32x4*)(d + c + 4) = a1 + acc[ai][bj][m][1]; } } }
    }
};
struct EpiGate {
    static constexpr bool PERM = true, AFTER_DRAIN = false;
    const bf16_t* xc; bf16_t* LA; bf16_t* BB; const float* b_a; const float* b_x; const float* lam;
    __device__ __forceinline__ void operator()(const f32x4 (&acc)[2][2][4][2], const Unit& u, int wr, int wc, int fr, int fq) const {
        const int row0 = u.pm * BM + wr * 64 + fr, ch0 = u.pn * 128 + wc * 32 + 8 * fq;
        float ba[8], bx[8], sp[8];
#pragma unroll
        for (int e = 0; e < 8; ++e) { ba[e] = b_a[ch0 + e]; bx[e] = b_x[ch0 + e]; sp[e] = lam[ch0 + e]; }
#pragma unroll
        for (int ai = 0; ai < 2; ++ai)
#pragma unroll
            for (int m = 0; m < 4; ++m) { const size_t row = (size_t)(row0 + ai * HALF + m * 16);
                if (u.pm * BM + wr * 64 + ai * HALF + m * 16 >= R) continue;
                const u32x4 xv = *(const u32x4*)(xc + row * DI + ch0);
                float la2[8], bb[8];
#pragma unroll
                for (int e = 0; e < 8; ++e) { const float ra = acc[ai][0][m][e >> 2][e & 3] + ba[e], ri = acc[ai][1][m][e >> 2][e & 3] + bx[e];
                    const float ea = 1.f + __expf(-ra), ei = 1.f + __expf(-ri), rc = __builtin_amdgcn_rcpf(ea * ei);
                    const float r = rc * ei, ig = rc * ea, l2 = -sp[e] * r;
                    const unsigned xw = xv[e >> 1]; const float xcv = (e & 1) ? bfhi(xw) : bflo(xw);
                    bb[e] = __builtin_amdgcn_sqrtf(fmaxf(1.0f - __builtin_amdgcn_exp2f(2.0f * l2), 0.f)) * ig * xcv; la2[e] = l2; }
                u32x4 w0, w1;
                w0.x = pk_h2(la2[0], la2[1]); w0.y = pk_h2(la2[2], la2[3]); w0.z = pk_h2(la2[4], la2[5]); w0.w = pk_h2(la2[6], la2[7]);
                w1.x = cvt_pk_bf16(bb[0], bb[1]); w1.y = cvt_pk_bf16(bb[2], bb[3]); w1.z = cvt_pk_bf16(bb[4], bb[5]); w1.w = cvt_pk_bf16(bb[6], bb[7]);
                *(u32x4*)(LA + row * DI + ch0) = w0; *(u32x4*)(BB + row * DI + ch0) = w1; }
    }
};

template <int LDA, int LDB, int KK, int APN, class Epi, class Sched, bool ALIGN_EPI = false, bool SP2 = false, int HALFPM = -1>
__device__ __forceinline__ void gemm_phase(PG8_LAS unsigned char* lds, const Gemm g, const Sched& S, const Epi& E, int wv) {
    const int tid = otid(wv), wid = wv, lane = tid & 63, wr = wid >> 2, wc = wid & 3, fr = lane & 15, fq = lane >> 4;
    constexpr int K = KK; int nt = K / BK; asm volatile("" : "+s"(nt));
    unsigned voffA[2], voffB[2];
#pragma unroll
    for (int i = 0; i < 2; ++i) { int R, C; stage_rc(tid * 16 + i * 8192, R, C); const int Rb = Epi::PERM ? ((R & ~31) + perm32(R & 31)) : R;
        voffA[i] = (unsigned)(R * LDA + C) * 2u; voffB[i] = (unsigned)(Rb * LDB + C) * 2u; }
    constexpr size_t kstep = (size_t)(BK * 2);
    constexpr size_t hstepA = (size_t)HALF * LDA * 2, hstepB = (size_t)HALF * LDB * 2;
    constexpr size_t tstepA = 2 * hstepA, tstepB = 2 * hstepB, apn = (size_t)APN * 2;
    const unsigned ldsw = (unsigned)wid * 1024u;
    const int aoff = lds_byte(wr * 64 + fr, fq * 8), boff = lds_byte(wc * 32 + fr, fq * 8);
#define PG8_SA(b, h) (((b) * 2 + (h)) * HTB)
#define PG8_SB(b, h) ((4 + (b) * 2 + (h)) * HTB)
#define PG8_STAGE(bufoff, gbase, voff) do { _Pragma("unroll") for (int _i = 0; _i < 2; ++_i) \
        __builtin_amdgcn_global_load_lds((const unsigned*)((const char*)(gbase) + (voff)[_i]), (PG8_LAS unsigned*)(lds + (bufoff) + ldsw + _i * 8192), 16, 0, 0); } while (0)
#define PG8_LDA(dst, b, h) do { _Pragma("unroll") for (int m = 0; m < 4; ++m) _Pragma("unroll") for (int k = 0; k < 2; ++k) dst[m][k] = *(const PG8_LAS bf16x8*)(lds + PG8_SA(b, h) + aoff + m * 2048 + k * 1024); } while (0)
#define PG8_LDB(dst, b, h) do { _Pragma("unroll") for (int n = 0; n < 2; ++n) _Pragma("unroll") for (int k = 0; k < 2; ++k) dst[n][k] = *(const PG8_LAS bf16x8*)(lds + PG8_SB(b, h) + boff + n * 2048 + k * 1024); } while (0)
#define PG8_MMA(ai, bj, At, Bt) do { __builtin_amdgcn_s_setprio(1); _Pragma("unroll") for (int m = 0; m < 4; ++m) _Pragma("unroll") for (int n = 0; n < 2; ++n) _Pragma("unroll") for (int k = 0; k < 2; ++k) \
        acc[ai][bj][m][n] = __builtin_amdgcn_mfma_f32_16x16x32_bf16(Bt[n][k], At[m][k], acc[ai][bj][m][n], 0, 0, 0); __builtin_amdgcn_s_setprio(0); } while (0)
#define PG8_WAIT_V(n) asm volatile("s_waitcnt vmcnt(" #n ")" ::: "memory")
#define PG8_WAIT_L(n) asm volatile("s_waitcnt lgkmcnt(" #n ")" ::: "memory")
#define PG8_BAR __builtin_amdgcn_s_barrier()
#define PG8_SCHED __builtin_amdgcn_sched_barrier(0)
    Unit cur, nxt; int ui = 0;
    if (!S.next(0, cur)) return;
    f32x4 acc[2][2][4][2];
#pragma unroll
    for (int a = 0; a < 2; ++a)
#pragma unroll
        for (int b = 0; b < 2; ++b)
#pragma unroll
            for (int m = 0; m < 4; ++m)
#pragma unroll
                for (int n = 0; n < 2; ++n) { f32x4 z_ = {0.f, 0.f, 0.f, 0.f}; asm volatile("" : "+v"(z_)); acc[a][b][m][n] = z_; }
    bf16x8 At[4][2], B0[2][2], B1[2][2];
    const char* cA = (const char*)g.A + (size_t)cur.pm * tstepA + (size_t)cur.pn * apn; const char* cB = (const char*)g.Bt + (size_t)cur.pn * tstepB;
    S.a_ready(cur);
    if constexpr (SP2) {
        PG8_STAGE(PG8_SB(0, 0), cB, voffB); PG8_STAGE(PG8_SB(0, 1), cB + hstepB, voffB); PG8_STAGE(PG8_SA(0, 0), cA, voffA); PG8_STAGE(PG8_SA(0, 1), cA + hstepA, voffA);
        if (wr == 1) PG8_BAR;
        PG8_WAIT_V(2); PG8_BAR;
        PG8_STAGE(PG8_SB(1, 0), cB + kstep, voffB); PG8_STAGE(PG8_SA(1, 0), cA + kstep, voffA); PG8_STAGE(PG8_SB(1, 1), cB + hstepB + kstep, voffB);
        PG8_WAIT_V(6); PG8_BAR;
    } else {
        PG8_STAGE(PG8_SB(0, 0), cB, voffB); PG8_STAGE(PG8_SA(0, 0), cA, voffA); PG8_STAGE(PG8_SB(0, 1), cB + hstepB, voffB); PG8_STAGE(PG8_SA(0, 1), cA + hstepA, voffA);
        if (wr == 1) PG8_BAR;
        PG8_WAIT_V(4); PG8_BAR;
        PG8_STAGE(PG8_SB(1, 0), cB + kstep, voffB); PG8_STAGE(PG8_SA(1, 0), cA + kstep, voffA); PG8_STAGE(PG8_SB(1, 1), cB + hstepB + kstep, voffB);
        PG8_WAIT_V(6); PG8_BAR;
    }
    for (;;) {
        const bool has_next = S.next(ui + 1, nxt);
        const char* nA = has_next ? (const char*)g.A + (size_t)nxt.pm * tstepA + (size_t)nxt.pn * apn : cA; const char* nB = has_next ? (const char*)g.Bt + (size_t)nxt.pn * tstepB : cB;
#pragma clang loop unroll(disable)
        for (int t = 0; t < nt; t += 2) {
            const bool last = (t == nt - 2);
            const char* a1 = cA + (size_t)(t + 1) * kstep;
            const char* a2 = last ? nA : cA + (size_t)(t + 2) * kstep; const char* b2 = last ? nB : cB + (size_t)(t + 2) * kstep;
            const char* a3 = a2 + kstep; const char* b3 = b2 + kstep;
            if (last && has_next) S.a_ready(nxt);
            if constexpr (SP2) {
            PG8_LDB(B0, 0, 0); PG8_LDB(B1, 0, 1); PG8_SCHED; PG8_LDA(At, 0, 0); PG8_STAGE(PG8_SA(1, 1), a1 + hstepA, voffA);
            PG8_WAIT_V(8); PG8_WAIT_L(0); PG8_BAR; PG8_MMA(0, 0, At, B0); PG8_MMA(0, 1, At, B1); PG8_BAR; PG8_SCHED;
            PG8_LDA(At, 0, 1); PG8_STAGE(PG8_SB(0, 0), b2, voffB); PG8_STAGE(PG8_SB(0, 1), b2 + hstepB, voffB); PG8_STAGE(PG8_SA(0, 0), a2, voffA);
            PG8_WAIT_V(8); PG8_WAIT_L(0); PG8_BAR; if (HALFPM < 0 || cur.pm != HALFPM) { PG8_MMA(1, 0, At, B0); PG8_MMA(1, 1, At, B1); } PG8_BAR; PG8_SCHED;
            PG8_LDB(B0, 1, 0); PG8_LDB(B1, 1, 1); PG8_SCHED; PG8_LDA(At, 1, 0); PG8_STAGE(PG8_SA(0, 1), a2 + hstepA, voffA);
            PG8_WAIT_V(8); PG8_WAIT_L(0); PG8_BAR; PG8_MMA(0, 0, At, B0); PG8_MMA(0, 1, At, B1); PG8_BAR; PG8_SCHED;
            PG8_LDA(At, 1, 1); PG8_STAGE(PG8_SB(1, 0), b3, voffB); PG8_STAGE(PG8_SB(1, 1), b3 + hstepB, voffB); PG8_STAGE(PG8_SA(1, 0), a3, voffA);
            PG8_WAIT_V(8); PG8_WAIT_L(0); PG8_BAR; if (HALFPM < 0 || cur.pm != HALFPM) { PG8_MMA(1, 0, At, B0); PG8_MMA(1, 1, At, B1); } PG8_BAR; PG8_SCHED;
            } else {
            PG8_LDB(B0, 0, 0); PG8_SCHED; PG8_LDA(At, 0, 0); PG8_STAGE(PG8_SA(1, 1), a1 + hstepA, voffA);
            PG8_WAIT_L(8); PG8_BAR; PG8_WAIT_L(0); PG8_MMA(0, 0, At, B0); PG8_BAR; PG8_SCHED;
            PG8_LDB(B1, 0, 1); PG8_STAGE(PG8_SB(0, 0), b2, voffB);
            PG8_BAR; PG8_WAIT_L(0); PG8_MMA(0, 1, At, B1); PG8_BAR;
            PG8_LDA(At, 0, 1); PG8_STAGE(PG8_SA(0, 0), a2, voffA);
            PG8_BAR; PG8_WAIT_L(0); PG8_MMA(1, 0, At, B0); PG8_BAR; PG8_SCHED;
            PG8_STAGE(PG8_SB(0, 1), b2 + hstepB, voffB);
            PG8_WAIT_V(6); PG8_BAR; PG8_MMA(1, 1, At, B1); PG8_BAR;
            PG8_LDB(B0, 1, 0); PG8_SCHED; PG8_LDA(At, 1, 0); PG8_STAGE(PG8_SA(0, 1), a2 + hstepA, voffA);
            PG8_WAIT_L(8); PG8_BAR; PG8_WAIT_L(0); PG8_MMA(0, 0, At, B0); PG8_BAR; PG8_SCHED;
            PG8_LDB(B1, 1, 1); PG8_STAGE(PG8_SB(1, 0), b3, voffB);
            PG8_BAR; PG8_WAIT_L(0); PG8_MMA(0, 1, At, B1); PG8_BAR;
            PG8_LDA(At, 1, 1); PG8_STAGE(PG8_SA(1, 0), a3, voffA);
            PG8_BAR; PG8_WAIT_L(0); PG8_MMA(1, 0, At, B0); PG8_BAR; PG8_SCHED;
            PG8_STAGE(PG8_SB(1, 1), b3 + hstepB, voffB);
            PG8_WAIT_V(6); PG8_BAR; PG8_MMA(1, 1, At, B1); PG8_BAR;
            }
        }
        if constexpr (ALIGN_EPI) { if (wr == 0) PG8_BAR; }
        if constexpr (!Epi::AFTER_DRAIN) { E(acc, cur, wr, wc, fr, fq); S.done(cur); }
        if (!has_next) break;
#pragma unroll
        for (int a = 0; a < 2; ++a)
#pragma unroll
            for (int b = 0; b < 2; ++b)
#pragma unroll
                for (int m = 0; m < 4; ++m)
#pragma unroll
                    for (int n = 0; n < 2; ++n) { f32x4 z_ = {0.f, 0.f, 0.f, 0.f}; asm volatile("" : "+v"(z_)); acc[a][b][m][n] = z_; }
        cur = nxt; cA = nA; cB = nB; ++ui;
        if constexpr (ALIGN_EPI) { if (wr == 1) PG8_BAR; }
    }
    PG8_WAIT_V(0);
    if constexpr (!ALIGN_EPI) { if (wr == 0) PG8_BAR; }
    PG8_BAR;
    if constexpr (Epi::AFTER_DRAIN) { E.fused(acc, cur, wr, wc, fr, fq, lds, wid, lane); S.done(cur); }
#undef PG8_SA
#undef PG8_SB
#undef PG8_STAGE
#undef PG8_LDA
#undef PG8_LDB
#undef PG8_MMA
#undef PG8_WAIT_V
#undef PG8_WAIT_L
#undef PG8_BAR
#undef PG8_SCHED
}
}

namespace att {
constexpr int NW = 8, QBLK = 32, KVBLK = 64;
constexpr float THR = 8.f;
#define SBAR() __builtin_amdgcn_sched_barrier(0)
__device__ __forceinline__ int crow(int r, int hi) { return (r & 3) + 8 * (r >> 2) + 4 * hi; }
__device__ __forceinline__ unsigned cvtpk(float lo, float hi) { unsigned r; asm volatile("v_cvt_pk_bf16_f32 %0, %1, %2" : "=v"(r) : "v"(lo), "v"(hi)); return r; }

template <int DQK> struct Cfg {
    static constexpr float SCALE = DQK == 192 ? 0.07216878364870322f : 0.08838834764831845f;
    static constexpr int KROWB = DQK * 2, SHM_V = KVBLK * 128 * 2, SHM_K = KVBLK * DQK * 2, KC = DQK / 64, ND0 = DQK / 16;
    static constexpr int NKA = DQK == 128 ? 1 : 4;
    static __device__ __forceinline__ int fsw(int r) { return DQK == 128 ? (r & 15) : ((r >> 1) & 7); }
    static constexpr int OFF_K = 3 * SHM_V, OFF_WS = 3 * SHM_V + 2 * SHM_K, LDS_NEED = OFF_WS + NW * 64 * 4;
};

template <int DQK>
__device__ __forceinline__ void partialSM(f32x16& p0, f32x16& p1, float& m_reg, float& mn, float& alpha) {
    constexpr float SCALE = Cfg<DQK>::SCALE, C = SCALE * 1.4426950408889634f;
    float pmax = p0[0];
#pragma unroll
    for (int r = 1; r < 16; ++r) pmax = fmaxf(pmax, p0[r]);
#pragma unroll
    for (int r = 0; r < 16; ++r) pmax = fmaxf(pmax, p1[r]);
    { auto rr = __builtin_amdgcn_permlane32_swap(__float_as_uint(pmax), __float_as_uint(pmax), false, false);
      pmax = fmaxf(__uint_as_float(rr[0]), __uint_as_float(rr[1])); }
    if (__builtin_expect(__all(pmax - m_reg <= THR / SCALE), 1)) { mn = m_reg; alpha = 1.f; }
    else { mn = fmaxf(m_reg, pmax); alpha = __builtin_amdgcn_exp2f((m_reg - mn) * C); m_reg = mn; }
    const float mnC = -mn * C;
#pragma unroll
    for (int r = 0; r < 16; ++r) p0[r] = fmaf(p0[r], C, mnC);
#pragma unroll
    for (int r = 0; r < 16; ++r) p1[r] = fmaf(p1[r], C, mnC);
#pragma unroll
    for (int r = 0; r < 16; ++r) p0[r] = __builtin_amdgcn_exp2f(p0[r]);
}
__device__ __forceinline__ void finishSM(f32x16& p0, f32x16& p1, float alpha, float& l_reg, bf16x8& pa0, bf16x8& pa1, bf16x8& pa2, bf16x8& pa3) {
#pragma unroll
    for (int r = 0; r < 16; ++r) p1[r] = __builtin_amdgcn_exp2f(p1[r]);
    float ps = 0;
#pragma unroll
    for (int r = 0; r < 16; ++r) ps += p0[r];
#pragma unroll
    for (int r = 0; r < 16; ++r) ps += p1[r];
    { auto rr = __builtin_amdgcn_permlane32_swap(__float_as_uint(ps), __float_as_uint(ps), false, false);
      ps = __uint_as_float(rr[0]) + __uint_as_float(rr[1]); }
    l_reg = l_reg * alpha + ps;
#define PK4(P, BASE, OUT) do { unsigned a0 = cvtpk(P[BASE + 0], P[BASE + 1]), a1 = cvtpk(P[BASE + 2], P[BASE + 3]);   \
    unsigned b0 = cvtpk(P[BASE + 4], P[BASE + 5]), b1 = cvtpk(P[BASE + 6], P[BASE + 7]);                              \
    auto r0 = __builtin_amdgcn_permlane32_swap(a0, b0, false, false); auto r1 = __builtin_amdgcn_permlane32_swap(a1, b1, false, false); \
    u32x4 w = {r0[0], r1[0], r0[1], r1[1]}; OUT = *reinterpret_cast<bf16x8*>(&w); } while (0)
    PK4(p0, 0, pa0); PK4(p0, 8, pa1); PK4(p1, 0, pa2); PK4(p1, 8, pa3);
#undef PK4
}
template <int DQK>
__device__ __forceinline__ void qkt(f32x16& p0, f32x16& p1, const char* Ks, const bf16x8* qr, const int (&ka)[Cfg<DQK>::NKA], int r32) {
    constexpr int KROWB = Cfg<DQK>::KROWB;
    { f32x16 z = {}; asm volatile("" : "+v"(z)); p0 = z; p1 = z; }
    int kf = DQK == 128 ? (r32 & 14) : 0; if (DQK == 128) asm volatile("" : "+v"(kf));
#define KOFF(d0_) (DQK == 128 ? ka[0] + (((2 * (d0_)) ^ kf) << 4) : ka[(d0_) & 3] + ((d0_) >> 2) * 128)
    bf16x8 c0 = *reinterpret_cast<const bf16x8*>(Ks + KOFF(0)), c1 = *reinterpret_cast<const bf16x8*>(Ks + KOFF(0) + 32 * KROWB);
#pragma unroll
    for (int d0 = 0; d0 < Cfg<DQK>::ND0; ++d0) {
        bf16x8 n0 = c0, n1 = c1;
        if (d0 + 1 < Cfg<DQK>::ND0) { n0 = *reinterpret_cast<const bf16x8*>(Ks + KOFF(d0 + 1)); n1 = *reinterpret_cast<const bf16x8*>(Ks + KOFF(d0 + 1) + 32 * KROWB); }
        p0 = __builtin_amdgcn_mfma_f32_32x32x16_bf16(c0, qr[d0], p0, 0, 0, 0);
        p1 = __builtin_amdgcn_mfma_f32_32x32x16_bf16(c1, qr[d0], p1, 0, 0, 0);
        c0 = n0; c1 = n1; }
#undef KOFF
}
__device__ __forceinline__ int v_st(int k, int c) { const int kk = (k & ~0xC) | ((k & 4) << 1) | ((k & 8) >> 1); return ((kk >> 3) * 4 + (c >> 5)) * 512 + ((kk & 7) * 32 + (c & 31)) * 2; }
__device__ __forceinline__ int v_rd_base(int lane) { return ((lane & 3) << 3) | (((lane >> 2) & 3) << 6) | (((lane >> 4) & 1) << 5) | (((lane >> 5) & 1) << 8); }
constexpr int v_rd_off(int d0, int ks, int half) { return d0 * 512 + ks * 4096 + half * 2048; }
template <int OFF> __device__ __forceinline__ s16x4 tr_read(int vb) {
    s16x4 r; asm volatile("ds_read_b64_tr_b16 %0, %1 offset:%2" : "=&v"(r) : "v"(vb), "i"(OFF) : "memory"); return r;
}
template <int D0> __device__ __forceinline__ void pv_one(f32x16& od, int vb, bf16x8 pa0, bf16x8 pa1, bf16x8 pa2, bf16x8 pa3) {
    const s16x4 l0 = tr_read<v_rd_off(D0, 0, 0)>(vb), h0 = tr_read<v_rd_off(D0, 0, 1)>(vb), l1 = tr_read<v_rd_off(D0, 1, 0)>(vb), h1 = tr_read<v_rd_off(D0, 1, 1)>(vb);
    const s16x4 l2 = tr_read<v_rd_off(D0, 2, 0)>(vb), h2 = tr_read<v_rd_off(D0, 2, 1)>(vb), l3 = tr_read<v_rd_off(D0, 3, 0)>(vb), h3 = tr_read<v_rd_off(D0, 3, 1)>(vb);
    asm volatile("s_waitcnt lgkmcnt(0)" ::: "memory"); SBAR();
#define PK(L, H) (bf16x8){L[0], L[1], L[2], L[3], H[0], H[1], H[2], H[3]}
    od = __builtin_amdgcn_mfma_f32_32x32x16_bf16(pa0, PK(l0, h0), od, 0, 0, 0);
    od = __builtin_amdgcn_mfma_f32_32x32x16_bf16(pa1, PK(l1, h1), od, 0, 0, 0);
    od = __builtin_amdgcn_mfma_f32_32x32x16_bf16(pa2, PK(l2, h2), od, 0, 0, 0);
    od = __builtin_amdgcn_mfma_f32_32x32x16_bf16(pa3, PK(l3, h3), od, 0, 0, 0);
#undef PK
}
__device__ __forceinline__ void pv_d0(f32x16* o, int vb, bf16x8 pa0, bf16x8 pa1, bf16x8 pa2, bf16x8 pa3) {
    pv_one<0>(o[0], vb, pa0, pa1, pa2, pa3); pv_one<1>(o[1], vb, pa0, pa1, pa2, pa3); pv_one<2>(o[2], vb, pa0, pa1, pa2, pa3); pv_one<3>(o[3], vb, pa0, pa1, pa2, pa3);
}
template <bool SWA>
__device__ __forceinline__ void mask_tile(f32x16& p0, f32x16& p1, int k0, int klo, int tq, int hi) {
#pragma unroll
    for (int r = 0; r < 16; ++r) {
        const int tk0 = k0 + crow(r, hi), tk1 = tk0 + 32;
        bool ok0 = tk0 >= klo, ok1 = tk1 >= klo;
        if (SWA) { const int d0 = tq - tk0, d1 = tq - tk1;
            ok0 = ok0 && (tk0 < NMETA || (d0 <= 128 && d0 >= -128)); ok1 = ok1 && (tk1 < NMETA || (d1 <= 128 && d1 >= -128)); }
        if (!ok0) p0[r] = -1e30f;
        if (!ok1) p1[r] = -1e30f;
    }
}

template <int DQK, int LDQ, int LDK, int LDV, bool SWA>
__device__ __forceinline__ void attn_unit(const bf16_t* __restrict__ Qb, const bf16_t* __restrict__ Kh, const bf16_t* __restrict__ Vh, bf16_t* Yg,
                                          int i0, int NT, int tfirst, float m_init, float l_init, char* lds, LAS unsigned char* ldsl, int wv, bool dostore, const float* gq) {
    using C = Cfg<DQK>;
    constexpr int SHM_V = C::SHM_V, SHM_K = C::SHM_K, KC = C::KC, KROWB = C::KROWB;
    const int tid = otid(wv), wid = wv, lane = tid & 63, r32 = lane & 31, hi = lane >> 5;
    char* V_lds = lds; char* K_lds = lds + C::OFF_K;
    float* wsp = (float*)(lds + C::OFF_WS) + wid * 64; float* li_l = wsp; float* al_l = wsp + 32;
    float m_reg = m_init, l_reg = l_init; f32x16 o[4]; bf16x8 qr[C::ND0];
#pragma unroll
    for (int d = 0; d < 4; ++d) { f32x16 z_ = {}; asm volatile("" : "+v"(z_)); o[d] = z_; }
    const int tq = i0 + wid * QBLK + r32;
    const bool wactive = i0 + wid * QBLK < T;
    { const int tqc = tq < T ? tq : T - 1; const bf16_t* Qw = Qb + (size_t)tqc * LDQ + hi * 8;
#pragma unroll
      for (int d0 = 0; d0 < C::ND0; ++d0) qr[d0] = *reinterpret_cast<const bf16x8*>(Qw + d0 * 16); }
    if constexpr (!SWA) {
        const int tqc = tq < T ? tq : T - 1;
        float ss = 0.f;
#pragma unroll
        for (int d0 = 0; d0 < C::ND0; ++d0) { const u32x4 w = __builtin_bit_cast(u32x4, qr[d0]);
#pragma unroll
            for (int e = 0; e < 4; ++e) { const float a = bflo(w[e]), b = bfhi(w[e]); ss += a * a + b * b; } }
        { auto rr = __builtin_amdgcn_permlane32_swap(__float_as_uint(ss), __float_as_uint(ss), false, false); ss = __uint_as_float(rr[0]) + __uint_as_float(rr[1]); }
        const float rstd = rsqrtf(ss * (1.f / 192.f) + EPS);
#pragma unroll
        for (int d0 = 0; d0 < 8; ++d0) { const u32x4 w = __builtin_bit_cast(u32x4, qr[d0]); const f32x4 g0 = *(const f32x4*)(gq + d0 * 16 + hi * 8), g1 = *(const f32x4*)(gq + d0 * 16 + hi * 8 + 4);
            u32x4 o_; o_[0] = cvtpk(bflo(w[0]) * rstd * g0[0], bfhi(w[0]) * rstd * g0[1]); o_[1] = cvtpk(bflo(w[1]) * rstd * g0[2], bfhi(w[1]) * rstd * g0[3]);
            o_[2] = cvtpk(bflo(w[2]) * rstd * g1[0], bfhi(w[2]) * rstd * g1[1]); o_[3] = cvtpk(bflo(w[3]) * rstd * g1[2], bfhi(w[3]) * rstd * g1[3]);
            qr[d0] = __builtin_bit_cast(bf16x8, o_); }
#pragma unroll
        for (int dd = 0; dd < 2; ++dd) { const u32x4 w1 = __builtin_bit_cast(u32x4, qr[8 + dd]), w2 = __builtin_bit_cast(u32x4, qr[10 + dd]);
            float y1[8], y2[8];
#pragma unroll
            for (int e = 0; e < 8; ++e) { const int ci = dd * 16 + hi * 8 + e;
                const float x1 = (e & 1) ? bfhi(w1[e >> 1]) : bflo(w1[e >> 1]), x2 = (e & 1) ? bfhi(w2[e >> 1]) : bflo(w2[e >> 1]);
                const float a1 = x1 * rstd * gq[128 + ci], a2 = x2 * rstd * gq[160 + ci];
                const float rev = __builtin_amdgcn_fractf((float)tqc * (exp2f(-(float)(2 * ci) * (13.287712379549449f / 64.f)) * 0.15915494309189535f));
                const float sn = __builtin_amdgcn_sinf(rev), cs = __builtin_amdgcn_cosf(rev);
                y1[e] = a1 * cs - a2 * sn; y2[e] = a1 * sn + a2 * cs; }
            u32x4 o1, o2;
#pragma unroll
            for (int e = 0; e < 4; ++e) { o1[e] = cvtpk(y1[2 * e], y1[2 * e + 1]); o2[e] = cvtpk(y2[2 * e], y2[2 * e + 1]); }
            qr[8 + dd] = __builtin_bit_cast(bf16x8, o1); qr[10 + dd] = __builtin_bit_cast(bf16x8, o2); }
    }
    unsigned koff[KC], voff[2];
#pragma unroll
    for (int i = 0; i < KC; ++i) { const int c = (wid * KC + i) * 64 + lane, row = c / (DQK / 8), pos = c % (DQK / 8); koff[i] = (unsigned)(row * LDK + (pos ^ C::fsw(row)) * 8); }
#pragma unroll
    for (int i = 0; i < 2; ++i) { const int o16 = ((wid * 2 + i) * 64 + lane) * 16, sub = o16 >> 9, within = o16 & 511, kk = (sub >> 2) * 8 + (within >> 6);
        const int vr = (kk & ~0xC) | ((kk & 4) << 1) | ((kk & 8) >> 1); voff[i] = (unsigned)(vr * LDV + (sub & 3) * 32 + ((within & 63) >> 1)); }
    int ka[C::NKA];
#pragma unroll
    for (int q4 = 0; q4 < C::NKA; ++q4) ka[q4] = r32 * KROWB + ((q4 * 32 + hi * 16) ^ (C::fsw(r32) << 4));
    if (DQK == 128) ka[0] = r32 * KROWB + ((hi ^ (r32 & 1)) << 4);
    const int vb0 = (int)(uintptr_t)V_lds + v_rd_base(lane);
    const bool hasmeta = SWA && tfirst > 0;
#define TKOFF(j) (SWA ? ((hasmeta && (j) == 0) ? 0 : (tfirst + (j) - (hasmeta ? 1 : 0)) * KVBLK) : (j) * KVBLK)
#define KA(j) (TKOFF(j) < T - KVBLK ? TKOFF(j) : T - KVBLK)
#define DMA(j_, ks_, vs_) do { const int k0__ = KA(j_); const bf16_t* kt_ = Kh + (size_t)k0__ * LDK; const bf16_t* vt_ = Vh + (size_t)k0__ * LDV; \
    _Pragma("unroll") for (int i = 0; i < KC; ++i) \
        __builtin_amdgcn_global_load_lds((const unsigned*)(kt_ + koff[i]), (LAS unsigned*)(ldsl + C::OFF_K + (ks_) * SHM_K + (wid * KC + i) * 1024), 16, 0, 0); \
    _Pragma("unroll") for (int i = 0; i < 2; ++i) \
        __builtin_amdgcn_global_load_lds((const unsigned*)(vt_ + voff[i]), (LAS unsigned*)(ldsl + (vs_) * SHM_V + (wid * 2 + i) * 1024), 16, 0, 0); } while (0)
#define LANDED() do { asm volatile("s_waitcnt vmcnt(0)" ::: "memory"); __syncthreads(); } while (0)
#define RESC(a) do { if (__any((a) < 1.f)) { if (hi == 0) al_l[r32] = (a); asm volatile("s_waitcnt lgkmcnt(0)" ::: "memory"); \
    _Pragma("unroll") for (int d = 0; d < 4; ++d) _Pragma("unroll") for (int r = 0; r < 16; ++r) o[d][r] *= al_l[crow(r, hi)]; } } while (0)
#define MASK(P0, P1, j) do { const int k0m = TKOFF(j); if (SWA || k0m + KVBLK > T) { int hi_ = hi; asm volatile("" : "+v"(hi_)); mask_tile<SWA>(P0, P1, KA(j), k0m, tq, hi_); } } while (0)
    f32x16 pA0, pA1, pB0, pB1; float mnA, mnB, alA, alB; bf16x8 pa0, pa1, pa2, pa3;
    if constexpr (SWA) {
        const int w0 = i0 + wid * QBLK;
        DMA(0, 0, 0); LANDED();
        for (int j = 0; j < NT; ++j) {
            const int sl = j & 1, k0n = TKOFF(j);
            if (j + 1 < NT) DMA(j + 1, sl ^ 1, sl ^ 1);
            if (wactive && (k0n == 0 || (k0n + KVBLK > w0 - 128 && k0n <= w0 + QBLK - 1 + 128))) {
                SBAR(); qkt<DQK>(pA0, pA1, K_lds + sl * SHM_K, qr, ka, r32);
                MASK(pA0, pA1, j); partialSM<DQK>(pA0, pA1, m_reg, mnA, alA);
                RESC(alA);
                finishSM(pA0, pA1, alA, l_reg, pa0, pa1, pa2, pa3); SBAR();
                pv_d0(o, vb0 + sl * SHM_V, pa0, pa1, pa2, pa3); }
            LANDED();
        }
    } else {
    DMA(0, 0, 0); LANDED();
    DMA(1, 1, 1);
    if (wactive) { qkt<DQK>(pA0, pA1, K_lds, qr, ka, r32); MASK(pA0, pA1, 0); partialSM<DQK>(pA0, pA1, m_reg, mnA, alA); }
    LANDED();
    int vprev = 0, vnext = 2;
    for (int j = 1; j + 1 < NT; j += 2) {
        DMA(j + 1, 0, vnext);
        if (wactive) { SBAR(); qkt<DQK>(pB0, pB1, K_lds + SHM_K, qr, ka, r32);
            finishSM(pA0, pA1, alA, l_reg, pa0, pa1, pa2, pa3); SBAR();
            pv_d0(o, vb0 + vprev * SHM_V, pa0, pa1, pa2, pa3); MASK(pB0, pB1, j); partialSM<DQK>(pB0, pB1, m_reg, mnB, alB);
            RESC(alB); }
        LANDED();
        vprev = vprev == 2 ? 0 : vprev + 1; vnext = vnext == 2 ? 0 : vnext + 1;
        DMA(j + 2, 1, vnext);
        if (wactive) { SBAR(); qkt<DQK>(pA0, pA1, K_lds, qr, ka, r32);
            finishSM(pB0, pB1, alB, l_reg, pa0, pa1, pa2, pa3); SBAR();
            pv_d0(o, vb0 + vprev * SHM_V, pa0, pa1, pa2, pa3); MASK(pA0, pA1, j + 1); partialSM<DQK>(pA0, pA1, m_reg, mnA, alA);
            RESC(alA); }
        LANDED();
        vprev = vprev == 2 ? 0 : vprev + 1; vnext = vnext == 2 ? 0 : vnext + 1;
    }
    if (wactive) {
        const int vb0t = (int)(uintptr_t)V_lds + v_rd_base(olane());
        SBAR(); qkt<DQK>(pB0, pB1, K_lds + SHM_K, qr, ka, r32);
        finishSM(pA0, pA1, alA, l_reg, pa0, pa1, pa2, pa3); SBAR();
        pv_d0(o, vb0t + vprev * SHM_V, pa0, pa1, pa2, pa3); MASK(pB0, pB1, NT - 1); partialSM<DQK>(pB0, pB1, m_reg, mnB, alB);
        RESC(alB);
        vprev = vprev == 2 ? 0 : vprev + 1;
        finishSM(pB0, pB1, alB, l_reg, pa0, pa1, pa2, pa3); SBAR();
        pv_d0(o, vb0t + vprev * SHM_V, pa0, pa1, pa2, pa3);
    }
    }
    if (hi == 0) li_l[r32] = l_reg; asm volatile("s_waitcnt lgkmcnt(0)" ::: "memory");
    const int le = olane(), r32e = le & 31, hie = le >> 5;
    float rli[16]; { const float* lib = li_l + 4 * hie;
#pragma unroll
    for (int r = 0; r < 16; ++r) rli[r] = __builtin_amdgcn_rcpf(lib[(r & 3) + 8 * (r >> 2)]); }
    __syncthreads();
    {
      bf16_t* stg = (bf16_t*)(lds + wid * (32 * 136 * 2)); bf16_t* stw = stg + hie * 4 * 136 + r32e;
#pragma unroll
      for (int r = 0; r < 16; ++r) { const int rowc = (r & 3) + 8 * (r >> 2);
#pragma unroll
          for (int d0 = 0; d0 < 4; ++d0) stw[rowc * 136 + d0 * 32] = f2bf(o[d0][r] * rli[r]); }
      asm volatile("s_waitcnt lgkmcnt(0)" ::: "memory");
#pragma unroll 1
      for (int half = 0; half < 2; ++half) {
          u32x4 gv[4], ov[4];
#pragma unroll
          for (int i4 = 0; i4 < 4; ++i4) { const int idx = (half * 4 + i4) * 64 + le, row = idx >> 4, c8 = (idx & 15) * 8, trow = i0 + wid * QBLK + row;
              ov[i4] = *(const u32x4*)(stg + row * 136 + c8);
              gv[i4] = (trow < T && dostore) ? *(const u32x4*)(Yg + (size_t)trow * EINP + c8) : (u32x4){0u, 0u, 0u, 0u}; }
#pragma unroll
          for (int i4 = 0; i4 < 4; ++i4) { const int idx = (half * 4 + i4) * 64 + le, row = idx >> 4, c8 = (idx & 15) * 8, trow = i0 + wid * QBLK + row;
              if (trow < T && dostore) { u32x4 w;
#pragma unroll
                  for (int e = 0; e < 4; ++e) w[e] = cvt_pk_bf16(bflo(ov[i4][e]) * siluf_(bflo(gv[i4][e])), bfhi(ov[i4][e]) * siluf_(bfhi(gv[i4][e])));
                  *(u32x4*)(Yg + (size_t)trow * EINP + c8) = w; } } } }
    __syncthreads();
#undef TKOFF
#undef KA
#undef DMA
#undef LANDED
#undef RESC
#undef MASK
}
}

__device__ __forceinline__ void xpose_item(const float* W, int K, int N, bf16_t* WT, float* scr, int item, int lane) {
    const int nblk = N / 32, kb = item / nblk, nb = item % nblk, k0 = 64 * kb, n0 = 32 * nb;
#pragma unroll 8
    for (int i = 0; i < 32; ++i) { const int kk = 2 * i + (lane >> 5); scr[kk * 33 + (lane & 31)] = W[(size_t)(k0 + kk) * N + n0 + (lane & 31)]; }
    asm volatile("s_waitcnt lgkmcnt(0)" ::: "memory");
    const int c = lane & 7;
#pragma unroll
    for (int j = 0; j < 4; ++j) { const int n = (lane >> 3) + 8 * j; const float* s = scr + (8 * c) * 33 + n;
        u32x4 o; o.x = cvt_pk_bf16(s[0 * 33], s[1 * 33]); o.y = cvt_pk_bf16(s[2 * 33], s[3 * 33]); o.z = cvt_pk_bf16(s[4 * 33], s[5 * 33]); o.w = cvt_pk_bf16(s[6 * 33], s[7 * 33]);
        *(u32x4*)(WT + (size_t)(n0 + n) * K + k0 + 8 * c) = o; }
    asm volatile("s_waitcnt lgkmcnt(0)" ::: "memory");
}
__device__ __forceinline__ void xpose_job(const float* W, int K, int N, bf16_t* WT, float* scr, int gw, int nw, int lane) {
    const int items = (K / 64) * (N / 32);
    for (int it = gw; it < items; it += nw) xpose_item(W, K, N, WT, scr, it, lane);
}
__device__ __forceinline__ void phase_weights(KP p, char* lds, int wv) {
    asm volatile("" : "+s"(p));
    const int tid = otid(wv), lane = tid & 63, wid = wv, gw = obid() * NWAVES + wid, nw = gridDim.x * NWAVES;
    float* scr = (float*)lds + wid * (64 * 33);
    unsigned char* ws = p->ws;
    for (int j = 0; j < 2; ++j) {
        xpose_job(p->in[3] + (size_t)j * DM * EIN, DM, EIN, (bf16_t*)(ws + WS_WINE) + (size_t)j * EINP * DM, scr, gw, nw, lane);
        xpose_job(p->in[6] + (size_t)j * 384 * 1536, 384, 1536, (bf16_t*)(ws + WS_WUQ) + (size_t)j * 1536 * 384, scr, gw, nw, lane);
        xpose_job(p->in[7] + (size_t)j * 256 * 2048, 256, 2048, (bf16_t*)(ws + WS_WUKV) + (size_t)j * 2048 * 256, scr, gw, nw, lane);
        xpose_job(p->in[13] + (size_t)j * DI * DM, DI, DM, (bf16_t*)(ws + WS_WOUTE) + (size_t)j * DM * DI, scr, gw, nw, lane);
        xpose_job(p->in[14] + (size_t)j * DM * OIN, DM, OIN, (bf16_t*)(ws + WS_WINO) + (size_t)j * OIN * DM, scr, gw, nw, lane);
        xpose_job(p->in[22] + (size_t)j * DI * DM, DI, DM, (bf16_t*)(ws + WS_WOUTO) + (size_t)j * DM * DI, scr, gw, nw, lane);
        for (int it = gw; it < 64 * 8; it += nw) { const int mat = it >> 3, sub = it & 7, dn = mat >> 1, gate = mat & 1;
            const float* src = (gate ? p->in[19] : p->in[17]) + ((size_t)j * 32 + dn) * 16384;
            bf16_t* dst = (bf16_t*)(ws + WS_WG) + (((size_t)j * 32 + dn) * 256 + gate * 128) * 128;
            xpose_item(src, 128, 128, dst, scr, sub, lane); }
        { float* spt = (float*)(ws + WS_SP) + (size_t)j * 2 * DI; const float* lamp = p->in[21] + (size_t)j * 2 * DI;
          for (int i = obid() * NTHR + tid; i < 2 * DI; i += gridDim.x * NTHR) spt[i] = 8.0f * log1pf(__expf(-lamp[i])) * 1.4426950408889634f; }
        { bf16_t* padp = (bf16_t*)(ws + WS_WINE) + (size_t)j * EINP * DM + (size_t)EIN * DM;
          for (int i = obid() * NTHR + tid; i < (EINP - EIN) * DM / 8; i += gridDim.x * NTHR) *(u32x4*)(padp + (size_t)i * 8) = (u32x4){0u, 0u, 0u, 0u}; }
    }
}
__device__ __forceinline__ void phase_norm(KP p, int layer, int g, int wv) {
    asm volatile("" : "+s"(p));
    const int tid = otid(wv), lane = tid & 63, gw = obid() * NWAVES + wv, nw = gridDim.x * NWAVES;
    const float* gn = p->in[2] + (size_t)layer * DM; bf16_t* z = (bf16_t*)(p->ws + A_Z);
    f32x4 gv[4];
#pragma unroll
    for (int j = 0; j < 4; ++j) gv[j] = *(const f32x4*)(gn + lane * 4 + 256 * j);
    const int nq = (R / 4 / nw) * nw;
    for (int lr = nq * 4 + gw; lr < R; lr += nw) {
        const int bl = lr / T, t = lr - bl * T; const float* src = h_src(p, layer, g * GB + bl, t);
        f32x4 v1[4]; float s1 = 0.f;
#pragma unroll
        for (int j = 0; j < 4; ++j) { v1[j] = *(const f32x4*)(src + lane * 4 + 256 * j); s1 += (v1[j].x * v1[j].x + v1[j].y * v1[j].y) + (v1[j].z * v1[j].z + v1[j].w * v1[j].w); }
        const float rstd = rsqrtf(wave_sum(s1) * (1.f / DM) + EPS);
#pragma unroll
        for (int j = 0; j < 4; ++j) { u32x2 o; o.x = cvt_pk_bf16(v1[j].x * rstd * gv[j].x, v1[j].y * rstd * gv[j].y); o.y = cvt_pk_bf16(v1[j].z * rstd * gv[j].z, v1[j].w * rstd * gv[j].w);
            *(u32x2*)(z + (size_t)lr * DM + lane * 4 + 256 * j) = o; }
    }
    for (int q = gw; q < nq; q += nw) {
        f32x4 v[4][4]; float s[4];
#pragma unroll
        for (int k = 0; k < 4; ++k) { const int lr = q * 4 + k, bl = lr / T, t = lr - bl * T; const float* src = h_src(p, layer, g * GB + bl, t);
#pragma unroll
            for (int j = 0; j < 4; ++j) v[k][j] = *(const f32x4*)(src + lane * 4 + 256 * j); }
#pragma unroll
        for (int k = 0; k < 4; ++k) { s[k] = 0.f;
#pragma unroll
            for (int j = 0; j < 4; ++j) s[k] += (v[k][j].x * v[k][j].x + v[k][j].y * v[k][j].y) + (v[k][j].z * v[k][j].z + v[k][j].w * v[k][j].w); }
#pragma unroll
        for (int k = 0; k < 4; ++k) { const float rstd = rsqrtf(wave_sum(s[k]) * (1.f / DM) + EPS); const int lr = q * 4 + k;
#pragma unroll
            for (int j = 0; j < 4; ++j) { u32x2 o; o.x = cvt_pk_bf16(v[k][j].x * rstd * gv[j].x, v[k][j].y * rstd * gv[j].y); o.y = cvt_pk_bf16(v[k][j].z * rstd * gv[j].z, v[k][j].w * rstd * gv[j].w);
                *(u32x2*)(z + (size_t)lr * DM + lane * 4 + 256 * j) = o; } }
    }
}
__device__ __forceinline__ void phase_prep_even(KP p, int j, int g, int wv) {
    asm volatile("" : "+s"(p));
    const int tid = otid(wv), lane = tid & 63, gw = obid() * NWAVES + wv, nw = gridDim.x * NWAVES;
    bf16_t* zp = (bf16_t*)(p->ws + A_ZP); bf16_t* cqn = (bf16_t*)(p->ws + A_CQN); bf16_t* ckvn = (bf16_t*)(p->ws + A_CKVN);
    const float* gq = p->in[4] + (size_t)j * 384; const float* gkv = p->in[5] + (size_t)j * 256;
    const float* sgq = p->in[10] + (size_t)j * 128; const float* sgk = p->in[11] + (size_t)j * 128;
    const float inv = exp2f(-(float)(2 * lane) * (13.287712379549449f / 128.f));
    const float gq1 = sgq[lane], gq2 = sgq[lane + 64], gk1 = sgk[lane], gk2 = sgk[lane + 64];
    for (int lr0 = gw * 2; lr0 < R; lr0 += nw * 2) {
        u32x4 vq[2], vkv[2]; float x1[2][10], x2[2][10];
#pragma unroll
        for (int k = 0; k < 2; ++k) { const bf16_t* zr = zp + (size_t)(lr0 + k) * EINP;
            vq[k] = (u32x4){0u, 0u, 0u, 0u}; vkv[k] = (u32x4){0u, 0u, 0u, 0u};
            if (lane < 48) vq[k] = *(const u32x4*)(zr + C_CQ + lane * 8);
            if (lane < 32) vkv[k] = *(const u32x4*)(zr + C_CKV + lane * 8);
#pragma unroll
            for (int hh = 0; hh < 10; ++hh) { const bf16_t* hp = zr + (hh < 8 ? C_QS + hh * 128 : C_KS + (hh - 8) * 128); x1[k][hh] = bf2f(hp[lane]); x2[k][hh] = bf2f(hp[lane + 64]); } }
#pragma unroll
        for (int k = 0; k < 2; ++k) { const int lr = lr0 + k, t = lr % T; bf16_t* zr = zp + (size_t)lr * EINP;
            { float ss = 0.f;
#pragma unroll
              for (int e = 0; e < 4; ++e) { const float a = bflo(vq[k][e]), b = bfhi(vq[k][e]); ss += a * a + b * b; }
              const float rstd = rsqrtf(wave_sum(ss) * (1.f / 384.f) + EPS);
              if (lane < 48) { u32x4 o;
#pragma unroll
                  for (int e = 0; e < 4; ++e) o[e] = cvt_pk_bf16(bflo(vq[k][e]) * rstd * gq[lane * 8 + 2 * e], bfhi(vq[k][e]) * rstd * gq[lane * 8 + 2 * e + 1]);
                  *(u32x4*)(cqn + (size_t)lr * 384 + lane * 8) = o; } }
            { float ss = 0.f;
#pragma unroll
              for (int e = 0; e < 4; ++e) { const float a = bflo(vkv[k][e]), b = bfhi(vkv[k][e]); ss += a * a + b * b; }
              const float rstd = rsqrtf(wave_sum(ss) * (1.f / 256.f) + EPS);
              if (lane < 32) { u32x4 o;
#pragma unroll
                  for (int e = 0; e < 4; ++e) o[e] = cvt_pk_bf16(bflo(vkv[k][e]) * rstd * gkv[lane * 8 + 2 * e], bfhi(vkv[k][e]) * rstd * gkv[lane * 8 + 2 * e + 1]);
                  *(u32x4*)(ckvn + (size_t)lr * 256 + lane * 8) = o; } }
            float sn, cs; sincosf((float)t * inv, &sn, &cs);
#pragma unroll
            for (int hh = 0; hh < 10; ++hh) {
                const float rstd = rsqrtf(wave_sum(x1[k][hh] * x1[k][hh] + x2[k][hh] * x2[k][hh]) * (1.f / 128.f) + EPS);
                const float y1 = x1[k][hh] * rstd * (hh < 8 ? gq1 : gk1), y2 = x2[k][hh] * rstd * (hh < 8 ? gq2 : gk2);
                x1[k][hh] = y1 * cs - y2 * sn; x2[k][hh] = y1 * sn + y2 * cs;
            }
#pragma unroll
            for (int hh = 0; hh < 10; ++hh) { bf16_t* hp = zr + (hh < 8 ? C_QS + hh * 128 : C_KS + (hh - 8) * 128); hp[lane] = f2bf(x1[k][hh]); hp[lane + 64] = f2bf(x2[k][hh]); } }
    }
}
__device__ __forceinline__ void phase_post_mla(KP p, int j, int g, int wv) {
    asm volatile("" : "+s"(p));
    const int tid = otid(wv), lane = tid & 63, gw = obid() * NWAVES + wv, nw = gridDim.x * NWAVES;
    const bf16_t* zp = (const bf16_t*)(p->ws + A_ZP); bf16_t* q = (bf16_t*)(p->ws + A_Q); bf16_t* kb = (bf16_t*)(p->ws + A_K);
    const float* gqn = p->in[8] + (size_t)j * 192; const float* gkn = p->in[9] + (size_t)j * 192;
    const float inv = exp2f(-(float)(2 * (lane & 31)) * (13.287712379549449f / 64.f));
    const float gq0 = gqn[2 * lane], gq1 = gqn[2 * lane + 1], gqr = gqn[128 + lane], gk0 = gkn[2 * lane], gk1 = gkn[2 * lane + 1], gkr = gkn[128 + lane];
    static_assert(R % 2 == 0, "two rows per wave step");
    for (int lr0 = gw * 2; lr0 < R; lr0 += nw * 2) {
        unsigned kn[2][8]; float pe[2], sn[2], cs[2];
#pragma unroll
        for (int k = 0; k < 2; ++k) { const int lr = lr0 + k; const bf16_t* krow = kb + (size_t)lr * 1536;
            pe[k] = bf2f(zp[(size_t)lr * EINP + C_KPE + lane]);
#pragma unroll
            for (int h = 0; h < 8; ++h) kn[k][h] = *(const unsigned*)(krow + h * 192 + 2 * lane); }
#pragma unroll
        for (int k = 0; k < 2; ++k) { const int lr = lr0 + k, t = lr % T; sincosf((float)t * inv, &sn[k], &cs[k]);
            bf16_t* krow = kb + (size_t)lr * 1536;
            const float pess = wave_sum(pe[k] * pe[k]);
#pragma unroll
            for (int h = 0; h < 8; ++h) {
                const float n0 = bflo(kn[k][h]), n1 = bfhi(kn[k][h]);
                const float rstd = rsqrtf((wave_sum(n0 * n0 + n1 * n1) + pess) * (1.f / 192.f) + EPS);
                kn[k][h] = cvt_pk_bf16(n0 * rstd * gk0, n1 * rstd * gk1);
                const float y = pe[k] * rstd * gkr; auto rr = __builtin_amdgcn_permlane32_swap(__float_as_uint(y), __float_as_uint(y), false, false);
                const float x1 = __uint_as_float(rr[0]), x2 = __uint_as_float(rr[1]);
                krow[h * 192 + 128 + lane] = f2bf(lane < 32 ? x1 * cs[k] - x2 * sn[k] : x1 * sn[k] + x2 * cs[k]);
            }
#pragma unroll
            for (int h = 0; h < 8; ++h) *(unsigned*)(krow + h * 192 + 2 * lane) = kn[k][h]; }
    }
}
__device__ __forceinline__ void phase_conv(KP p, int j, int wv) {
    asm volatile("" : "+s"(p));
    const bf16_t* u = (const bf16_t*)(p->ws + A_ZP); bf16_t* xc = (bf16_t*)(p->ws + A_XC);
    const float* cw = p->in[15] + (size_t)j * 4 * DI; const float* cb = p->in[16] + (size_t)j * DI;
    static_assert(T % 16 == 0 && R % 16 == 0, "conv strips");
    const int nthr = gridDim.x * NTHR, nst = ((R / 16) * (DI / 8) / nthr) * nthr;
    for (int task = obid() * NTHR + otid(wv); task < (R - (nst >> 8) * 16) * (DI / 8); task += nthr) {
        const int lr = (nst >> 8) * 16 + (task >> 8), c0 = (task & 255) * 8, t = lr % T;
        float acc[8];
#pragma unroll
        for (int e = 0; e < 8; ++e) acc[e] = cb[c0 + e];
#pragma unroll
        for (int tap = 0; tap < 4; ++tap) { const int tt = t + tap - 2;
            if (tt >= 0 && tt < T) { const u32x4 v = *(const u32x4*)(u + (size_t)(lr + tap - 2) * OIN + c0); const float* w = cw + tap * DI + c0;
#pragma unroll
                for (int e = 0; e < 4; ++e) { acc[2 * e] += bflo(v[e]) * w[2 * e]; acc[2 * e + 1] += bfhi(v[e]) * w[2 * e + 1]; } } }
        u32x4 o;
#pragma unroll
        for (int e = 0; e < 4; ++e) o[e] = cvt_pk_bf16(acc[2 * e], acc[2 * e + 1]);
        *(u32x4*)(xc + (size_t)lr * DI + c0) = o;
    }
    for (int task = obid() * NTHR + otid(wv); task < nst; task += nthr) {
        const int c0 = (task & 255) * 8, lr0 = (task >> 8) * 16, t0 = lr0 % T;
        float w[4][8], bias[8];
#pragma unroll
        for (int e = 0; e < 8; ++e) { bias[e] = cb[c0 + e];
#pragma unroll
            for (int tap = 0; tap < 4; ++tap) w[tap][e] = cw[tap * DI + c0 + e]; }
        u32x4 rows[19];
#pragma unroll
        for (int k = 0; k < 19; ++k) { const int tt = t0 + k - 2;
            rows[k] = (tt >= 0 && tt < T) ? *(const u32x4*)(u + (size_t)(lr0 + k - 2) * OIN + c0) : (u32x4){0u, 0u, 0u, 0u}; }
#pragma unroll
        for (int r = 0; r < 16; ++r) { float acc[8];
#pragma unroll
            for (int e = 0; e < 8; ++e) acc[e] = bias[e];
#pragma unroll
            for (int tap = 0; tap < 4; ++tap) { const u32x4 v = rows[r + tap];
#pragma unroll
                for (int e = 0; e < 4; ++e) { acc[2 * e] += bflo(v[e]) * w[tap][2 * e]; acc[2 * e + 1] += bfhi(v[e]) * w[tap][2 * e + 1]; } }
            u32x4 o;
#pragma unroll
            for (int e = 0; e < 4; ++e) o[e] = cvt_pk_bf16(acc[2 * e], acc[2 * e + 1]);
            *(u32x4*)(xc + (size_t)(lr0 + r) * DI + c0) = o; }
    }
}
__device__ __forceinline__ int chunk_start(int k) { return (k * T) / NCH; }
__device__ __forceinline__ void phase_scan_a(KP p, int d, int wv) {
    asm volatile("" : "+s"(p));
    const bf16_t* LA = (const bf16_t*)(p->ws + A_LA); const bf16_t* BB = (const bf16_t*)(p->ws + A_BB);
    float* CP = (float*)(p->ws + WS_CARP); float* CH = (float*)(p->ws + WS_CARH);
    for (int task = obid() * NTHR + otid(wv); task < GB * NCH * (DI / 4); task += gridDim.x * NTHR) {
        const int cp = task & 511, ck = (task >> 9) & (NCH - 1), bl = task / (512 * NCH);
        const int t0 = chunk_start(ck), t1 = chunk_start(ck + 1), n = t1 - t0;
        const size_t base = (size_t)bl * T * DI + 4 * cp;
        float s[4] = {0.f, 0.f, 0.f, 0.f}, h[4] = {0.f, 0.f, 0.f, 0.f};
        for (int i0 = 0; i0 < n; i0 += 16) { const int nb = n - i0;
            u32x2 la[16], bb[16];
#pragma unroll
            for (int k = 0; k < 16; ++k) if (k < nb) { const int t = d == 0 ? t0 + i0 + k : t1 - 1 - i0 - k;
                la[k] = *(const u32x2*)(LA + base + (size_t)t * DI); bb[k] = *(const u32x2*)(BB + base + (size_t)t * DI); }
#pragma unroll
            for (int k = 0; k < 16; ++k) if (k < nb) {
                const float l0 = h2lo(la[k].x), l1 = h2hi(la[k].x), l2 = h2lo(la[k].y), l3 = h2hi(la[k].y);
                h[0] = __builtin_amdgcn_exp2f(l0) * h[0] + bflo(bb[k].x); h[1] = __builtin_amdgcn_exp2f(l1) * h[1] + bfhi(bb[k].x);
                h[2] = __builtin_amdgcn_exp2f(l2) * h[2] + bflo(bb[k].y); h[3] = __builtin_amdgcn_exp2f(l3) * h[3] + bfhi(bb[k].y);
                s[0] += l0; s[1] += l1; s[2] += l2; s[3] += l3; } }
        const size_t ci = ((size_t)bl * NCH + ck) * DI + 4 * cp;
        *(f32x4*)(CP + ci) = (f32x4){__builtin_amdgcn_exp2f(s[0]), __builtin_amdgcn_exp2f(s[1]), __builtin_amdgcn_exp2f(s[2]), __builtin_amdgcn_exp2f(s[3])};
        *(f32x4*)(CH + ci) = (f32x4){h[0], h[1], h[2], h[3]};
    }
}
__device__ __forceinline__ void phase_scan_b(KP p, int d, int wv) {
    asm volatile("" : "+s"(p));
    const bf16_t* LA = (const bf16_t*)(p->ws + A_LA); const bf16_t* BB = (const bf16_t*)(p->ws + A_BB);
    bf16_t* zp = (bf16_t*)(p->ws + A_ZP);
    const float* CP = (const float*)(p->ws + WS_CARP); const float* CH = (const float*)(p->ws + WS_CARH);
    for (int task = obid() * NTHR + otid(wv); task < GB * NCH * (DI / 4); task += gridDim.x * NTHR) {
        const int cp = task & 511, ck = (task >> 9) & (NCH - 1), bl = task / (512 * NCH);
        const int t0 = chunk_start(ck), t1 = chunk_start(ck + 1), n = t1 - t0;
        f32x4 h = {0.f, 0.f, 0.f, 0.f};
        { const int nprev = d == 0 ? ck : NCH - 1 - ck;
          for (int i = 0; i < nprev; ++i) { const int c = d == 0 ? i : NCH - 1 - i; const size_t ci = ((size_t)bl * NCH + c) * DI + 4 * cp;
              const f32x4 P = *(const f32x4*)(CP + ci), H = *(const f32x4*)(CH + ci); h = P * h + H; } }
        const size_t base = (size_t)bl * T * DI + 4 * cp; const size_t ybase = (size_t)bl * T * OIN + 4 * cp;
        for (int i0 = 0; i0 < n; i0 += 16) { const int nb = n - i0;
            u32x2 la[16], bb[16], yv[16], gv[16];
#pragma unroll
            for (int k = 0; k < 16; ++k) if (k < nb) { const int t = d == 0 ? t0 + i0 + k : t1 - 1 - i0 - k;
                la[k] = __builtin_nontemporal_load((const u32x2*)(LA + base + (size_t)t * DI)); bb[k] = __builtin_nontemporal_load((const u32x2*)(BB + base + (size_t)t * DI));
                if (d != 0) { yv[k] = *(const u32x2*)(zp + ybase + (size_t)t * OIN); gv[k] = __builtin_nontemporal_load((const u32x2*)(zp + ybase + (size_t)t * OIN + DI)); } }
#pragma unroll
            for (int k = 0; k < 16; ++k) if (k < nb) { const int t = d == 0 ? t0 + i0 + k : t1 - 1 - i0 - k;
                h[0] = __builtin_amdgcn_exp2f(h2lo(la[k].x)) * h[0] + bflo(bb[k].x); h[1] = __builtin_amdgcn_exp2f(h2hi(la[k].x)) * h[1] + bfhi(bb[k].x);
                h[2] = __builtin_amdgcn_exp2f(h2lo(la[k].y)) * h[2] + bflo(bb[k].y); h[3] = __builtin_amdgcn_exp2f(h2hi(la[k].y)) * h[3] + bfhi(bb[k].y);
                u32x2 o;
                if (d == 0) { o.x = cvt_pk_bf16(h[0], h[1]); o.y = cvt_pk_bf16(h[2], h[3]); }
                else { o.x = cvt_pk_bf16((bflo(yv[k].x) + h[0]) * siluf_(bflo(gv[k].x)), (bfhi(yv[k].x) + h[1]) * siluf_(bfhi(gv[k].x)));
                       o.y = cvt_pk_bf16((bflo(yv[k].y) + h[2]) * siluf_(bflo(gv[k].y)), (bfhi(yv[k].y) + h[3]) * siluf_(bfhi(gv[k].y))); }
                *(u32x2*)(zp + ybase + (size_t)t * OIN) = o; } }
    }
}

__device__ __forceinline__ void phase_attn(KP p, int j, char* lds, int wv) {
    asm volatile("" : "+s"(p));
    const int G = gridDim.x, bx = obid(), vcu = (G % 8 == 0) ? (bx % 8) * (G / 8) + bx / 8 : bx;
    bf16_t* zp = (bf16_t*)(p->ws + A_ZP); const bf16_t* q = (const bf16_t*)(p->ws + A_Q); const bf16_t* kb = (const bf16_t*)(p->ws + A_K); const bf16_t* vb = (const bf16_t*)(p->ws + A_V);
    constexpr int NFULL = GB * 8 * 16, NTAIL = GB * 8, NSWA = GB * 8 * 17;
#ifndef ATT_REP
#define ATT_REP 1
#endif
    const int nfl = (NFULL - vcu + G - 1) / G;
    const bool split = G > NTAIL; const int nsw = split ? G - NTAIL : G, sb = split ? vcu - NTAIL : vcu;
    const int ntl = split ? (vcu < NTAIL ? 1 : 0) : (NTAIL - vcu + G - 1) / G;
    const int nsv = sb >= 0 ? (NSWA - sb + nsw - 1) / nsw : 0;
    for (int rp = 0; rp < ATT_REP; ++rp)
    for (int it = 0; it < nfl + ntl + nsv; ++it) {
        const bool dostore = rp == ATT_REP - 1;
        if (it < nfl + ntl) {
            int bh, qb; if (it < nfl) { const int u = vcu + it * G; bh = u >> 4; qb = u & 15; } else { bh = vcu + (it - nfl) * G; qb = 16; }
            const int bl = bh >> 3, h = bh & 7; const size_t r0 = (size_t)bl * T;
            att::attn_unit<192, 1536, 1536, 1024, false>(q + r0 * 1536 + h * 192, kb + r0 * 1536 + h * 192, vb + r0 * 1024 + h * 128,
                                                          zp + r0 * EINP + C_GATE + h * 128, qb * 256, 66, 0, -1e30f, 0.f, lds, (LAS unsigned char*)lds, wv, dostore, p->in[8] + (size_t)j * 192);
        } else {
            const int v = sb + (it - nfl - ntl) * nsw, bh = v / 17, qb = v - bh * 17, bl = bh >> 3, h = bh & 7, kvh = h >> 2; const size_t r0 = (size_t)bl * T;
            const int i0 = qb * 256, t64 = i0 / 64, tfirst = t64 >= 2 ? t64 - 2 : 0, tlast = t64 + 6 < 65 ? t64 + 6 : 65;
            int n = tlast - tfirst + (tfirst > 0 ? 1 : 0); n = (n + 1) & ~1;
            const float sink = p->in[12][j * 8 + h];
            att::attn_unit<128, EINP, EINP, EINP, true>(zp + r0 * EINP + C_QS + h * 128, zp + r0 * EINP + C_KS + kvh * 128, zp + r0 * EINP + C_VS + kvh * 128,
                                                         zp + r0 * EINP + C_GATE + 1024 + h * 128, i0, n, tfirst, sink * 11.313708498984761f, 1.f, lds, (LAS unsigned char*)lds, wv, dostore, nullptr);
        }
    }
}

#define XB_TMO      128
#define XB_XCNT(j)  (256  + 64 * (j))
#define XB_XSUB(j)  (1280 + 64 * (j))
#define XB_XGEN(j)  (2304 + 64 * (j))
#define XB_TOP      3328
#define XB_TOPGEN   3392
#define XCD_BAR_WORDS 3456
#define XB_SPIN_CAP (1u << 20)
__device__ __forceinline__ unsigned xb_ld(unsigned* p)              { return __hip_atomic_load(p, __ATOMIC_RELAXED, __HIP_MEMORY_SCOPE_AGENT); }
__device__ __forceinline__ unsigned xb_add(unsigned* p, unsigned v) { return __hip_atomic_fetch_add(p, v, __ATOMIC_RELAXED, __HIP_MEMORY_SCOPE_AGENT); }
__device__ __forceinline__ unsigned xb_xcc_id() { return (unsigned)__builtin_amdgcn_s_getreg((3 << 11) | 20) & 0xFu; }
#define XB_SPIN(cond, bar) do { unsigned _sp = 0; while (cond) { __builtin_amdgcn_s_sleep(1); \
    if ((++_sp & 255u) == 0u) { if (xb_ld(&(bar)[XB_TMO])) break; if (_sp > XB_SPIN_CAP) { atomicAdd(&(bar)[XB_TMO], 1u); break; } } } } while (0)
__device__ __forceinline__ void xcd_barrier_complete(unsigned* bar, unsigned x, unsigned G, unsigned& nloc, unsigned& nx) {
    unsigned sum, cnt, mine, sp = 0u;
    for (;;) {
        sum = 0u; cnt = 0u; mine = 0u;
#pragma unroll
        for (unsigned j = 0; j < 16; ++j) { const unsigned c = xb_ld(&bar[XB_XCNT(j)]); sum += c; cnt += (c > 0u) ? 1u : 0u; mine = (j == x) ? c : mine; }
        if (sum == G) break;
        __builtin_amdgcn_s_sleep(1);
        if ((++sp & 255u) == 0u) { if (xb_ld(&bar[XB_TMO])) break; if (sp > XB_SPIN_CAP) { atomicAdd(&bar[XB_TMO], 1u); break; } }
    }
    nloc = mine > 0u ? mine : 1u; nx = cnt > 0u ? cnt : 1u;
}
__device__ __forceinline__ void grid_bar(unsigned* bar, unsigned x, volatile LAS unsigned* st, unsigned G, int wv, int lane) {
    asm volatile("s_waitcnt vmcnt(0)" ::: "memory");
    __syncthreads();
    if (wv == 0 && lane == 0) {
        __builtin_amdgcn_s_waitcnt(0);
        unsigned nloc = st[0], nx = st[1];
        if (nloc == 0u) { xcd_barrier_complete(bar, x, G, nloc, nx); st[0] = nloc; st[1] = nx; }
        const unsigned old = xb_add(&bar[XB_XSUB(x)], 1u);
        const unsigned gen = old / nloc;
        if (old + 1u == (gen + 1u) * nloc) {
            __builtin_amdgcn_fence(__ATOMIC_RELEASE, "agent");
            asm volatile("s_waitcnt vmcnt(0)" ::: "memory");
            const unsigned og = xb_add(&bar[XB_TOP], 1u);
            const unsigned tg = og / nx;
            if (og + 1u == (tg + 1u) * nx) xb_add(&bar[XB_TOPGEN], 1u);
            else XB_SPIN(xb_ld(&bar[XB_TOPGEN]) == tg, bar);
            __builtin_amdgcn_fence(__ATOMIC_ACQUIRE, "agent");
            xb_add(&bar[XB_XGEN(x)], 1u);
            asm volatile("s_waitcnt vmcnt(0)" ::: "memory");
        } else {
            XB_SPIN(xb_ld(&bar[XB_XGEN(x)]) == gen, bar);
            __builtin_amdgcn_fence(__ATOMIC_ACQUIRE, "agent");
            asm volatile("s_waitcnt vmcnt(0)" ::: "memory");
        }
    }
    __syncthreads();
}

__global__ void __launch_bounds__(NTHR, 2) hybrid_fwd(Params p_unused) {
    extern __shared__ __attribute__((aligned(16))) unsigned char lds[];
    const int wv = __builtin_amdgcn_readfirstlane((int)(threadIdx.x >> 6));
    const unsigned G = gridDim.x;
    LAS unsigned char* ldsl = (LAS unsigned char*)lds;
    KP kp = (KP)__builtin_amdgcn_kernarg_segment_ptr();
    unsigned* barw = (unsigned*)(kp->ws + WS_BAR);
    volatile LAS unsigned* bst = (volatile LAS unsigned*)(ldsl + 131072 + 64);
    const unsigned xcc = xb_xcc_id();
    if (threadIdx.x == 0) { bst[0] = 0u; bst[1] = 0u; (void)xb_add(&barw[XB_XCNT(xcc)], 1u); }
    __syncthreads();
#define GBAR() do { grid_bar(barw, xcc, bst, G, wv, olane()); } while (0)
    phase_weights(kp, (char*)lds, wv);
    phase_norm(kp, 0, 0, wv);
    if (gridDim.y == 0x7fffffffu) cg::this_grid().sync();
    GBAR();
    for (int g = 0; g < NG; ++g) {
        for (int layer = 0; layer < 4; ++layer) {
            const int j = layer >> 1, bx = obid();
            if (layer != 0) { phase_norm(kp, layer, g, wv); GBAR(); }
            KP p = kp; asm volatile("" : "+s"(p));
            unsigned char* ws = p->ws;
            if ((layer & 1) == 0) {
                { pg8::Gemm gm{(const bf16_t*)(ws + A_Z), (const bf16_t*)(ws + WS_WINE) + (size_t)j * EINP * DM}; pg8::StaticOrder S; S.init(RP, EINP, G, bx);
                  pg8::EpiStore E{(bf16_t*)(ws + A_ZP), EINP};
                  pg8::gemm_phase<DM, DM, DM, 0, pg8::EpiStore, pg8::StaticOrder, false, true>(ldsl, gm, S, E, wv); }
                GBAR();
                phase_prep_even(kp, j, g, wv);
                GBAR();
                { pg8::Gemm gm{(const bf16_t*)(ws + A_CQN), (const bf16_t*)(ws + WS_WUQ) + (size_t)j * 1536 * 384}; pg8::StaticOrder S; S.init(RP, 1536, G, bx);
                  pg8::EpiStore E{(bf16_t*)(ws + A_Q), 1536};
                  pg8::gemm_phase<384, 384, 384, 0, pg8::EpiStore, pg8::StaticOrder, true, true>(ldsl, gm, S, E, wv); }
                { pg8::Gemm gm{(const bf16_t*)(ws + A_CKVN), (const bf16_t*)(ws + WS_WUKV) + (size_t)j * 2048 * 256}; pg8::StaticOrder S; S.init(RP, 2048, G, bx);
                  pg8::EpiKV E{(bf16_t*)(ws + A_K), (bf16_t*)(ws + A_V)};
                  pg8::gemm_phase<256, 256, 256, 0, pg8::EpiKV, pg8::StaticOrder, true, true>(ldsl, gm, S, E, wv); }
                GBAR();
                phase_post_mla(kp, j, g, wv);
                GBAR();
                phase_attn(kp, j, (char*)lds, wv);
                GBAR();
                { pg8::Gemm gm{(const bf16_t*)(ws + A_ZP) + C_GATE, (const bf16_t*)(ws + WS_WOUTE) + (size_t)j * DM * DI}; pg8::TailOrder S; S.init(RP, DM, G, bx);
                  pg8::EpiRes E{p->in[0], p->in[1], p->out, (float*)(ws + WS_HMETA), layer, g};
                  pg8::gemm_phase<EINP, DI, DI, 0, pg8::EpiRes, pg8::TailOrder, true, true, RP / 256 - 1>(ldsl, gm, S, E, wv); }
                GBAR();
            } else {
                { pg8::Gemm gm{(const bf16_t*)(ws + A_Z), (const bf16_t*)(ws + WS_WINO) + (size_t)j * OIN * DM}; pg8::StaticOrder S; S.init(RP, OIN, G, bx);
                  pg8::EpiStore E{(bf16_t*)(ws + A_ZP), OIN};
                  pg8::gemm_phase<DM, DM, DM, 0, pg8::EpiStore, pg8::StaticOrder, false, true>(ldsl, gm, S, E, wv); }
                GBAR();
                phase_conv(kp, j, wv);
                GBAR();
                for (int d = 0; d < 2; ++d) {
                    { pg8::Gemm gm{(const bf16_t*)(ws + A_XC), (const bf16_t*)(ws + WS_WG) + (size_t)(j * 2 + d) * 16 * 256 * 128}; pg8::TailOrder S; S.init(RP, 16 * 256, G, bx);
                      pg8::EpiGate E{(const bf16_t*)(ws + A_XC), (bf16_t*)(ws + A_LA), (bf16_t*)(ws + A_BB),
                                     p->in[18] + (size_t)(j * 2 + d) * DI, p->in[20] + (size_t)(j * 2 + d) * DI, (const float*)(ws + WS_SP) + (size_t)(j * 2 + d) * DI};
                      pg8::gemm_phase<DI, 128, 128, 128, pg8::EpiGate, pg8::TailOrder, true, true>(ldsl, gm, S, E, wv); }
                    GBAR();
                    phase_scan_a(kp, d, wv);
                    GBAR();
                    phase_scan_b(kp, d, wv);
                    GBAR();
                }
                { pg8::Gemm gm{(const bf16_t*)(ws + A_ZP), (const bf16_t*)(ws + WS_WOUTO) + (size_t)j * DM * DI}; pg8::TailOrder S; S.init(RP, DM, G, bx);
                  pg8::EpiRes E{p->in[0], p->in[1], p->out, (float*)(ws + WS_HMETA), layer, g};
                  pg8::gemm_phase<OIN, DI, DI, 0, pg8::EpiRes, pg8::TailOrder, true, true, RP / 256 - 1>(ldsl, gm, S, E, wv); }
                if (layer == 3 && g + 1 < NG) phase_norm(kp, 0, g + 1, wv);
                GBAR();
            }
        }
    }
#undef GBAR
}

extern "C" void kernel_launch(void* const* d_in, const int* in_sizes, int n_in, void* d_out, int out_size, void* d_ws, size_t ws_size, hipStream_t stream) {
    static int grid = 0;
    if (grid == 0) {
        if (n_in != 23 || out_size != NBATCH * SEQ * DM || ws_size < WS_NEED) { fprintf(stderr, "kernel_launch: unexpected shapes (n_in %d out %d ws %zu need %zu)\n", n_in, out_size, ws_size, (size_t)WS_NEED); grid = -1; return; }
        int dev = 0, cus = 0, per_cu = 0;
        hipGetDevice(&dev); hipDeviceGetAttribute(&cus, hipDeviceAttributeMultiprocessorCount, dev);
        if (hipFuncSetAttribute((const void*)hybrid_fwd, hipFuncAttributeMaxDynamicSharedMemorySize, LDS_BYTES) != hipSuccess) { fprintf(stderr, "kernel_launch: hipFuncSetAttribute failed\n"); grid = -1; return; }
        if (hipOccupancyMaxActiveBlocksPerMultiprocessor(&per_cu, (const void*)hybrid_fwd, NTHR, LDS_BYTES) != hipSuccess || per_cu < 1) { fprintf(stderr, "kernel_launch: occupancy query failed (%d)\n", per_cu); per_cu = 1; (void)hipGetLastError(); }
        grid = cus * per_cu;
    }
    if (grid < 0) return;
    Params p{};
    for (int i = 0; i < 23; ++i) p.in[i] = (const float*)d_in[i];
    p.out = (float*)d_out; p.ws = (unsigned char*)d_ws;
    (void)hipMemsetAsync((char*)d_ws + WS_BAR, 0, 16384, stream);
    void* args[] = {&p};
    hipError_t e = hipLaunchCooperativeKernel((const void*)hybrid_fwd, dim3(grid), dim3(NTHR), args, LDS_BYTES, stream);
    if (e != hipSuccess) fprintf(stderr, "cooperative launch failed: %s (grid %d)\n", hipGetErrorString(e), grid);
}
```

```cpp
#include <hip/hip_runtime.h>
#include <hip/hip_cooperative_groups.h>
#include <cstdio>
#include <cstdint>
namespace cg = cooperative_groups;

constexpr int NBATCH = 8, SEQ = 4096, NMETA = 16, T = SEQ + NMETA, DM = 1024, DI = 2048;
constexpr int GB = 4, NG = NBATCH / GB, R = GB * T, RP = ((R + 255) / 256) * 256;
constexpr int EIN = 4288, EINP = 4352, OIN = 4096;
constexpr int C_CQ = 0, C_CKV = 384, C_KPE = 640, C_QS = 704, C_KS = 1728, C_VS = 1984, C_GATE = 2240;
constexpr float EPS = 1e-6f;
constexpr int NCH = 64;
constexpr int NWAVES = 8, NTHR = 512;
constexpr int LDS_BYTES = 139264;

constexpr size_t al256(size_t x) { return (x + 255) / 256 * 256; }
constexpr size_t WS_WINE = 0;
constexpr size_t WS_WUQ = WS_WINE + (size_t)2 * EINP * DM * 2;
constexpr size_t WS_WUKV = WS_WUQ + (size_t)2 * 1536 * 384 * 2;
constexpr size_t WS_WOUTE = WS_WUKV + (size_t)2 * 2048 * 256 * 2;
constexpr size_t WS_WINO = WS_WOUTE + (size_t)2 * DM * DI * 2;
constexpr size_t WS_WOUTO = WS_WINO + (size_t)2 * OIN * DM * 2;
constexpr size_t WS_WG = WS_WOUTO + (size_t)2 * DM * DI * 2;
constexpr size_t WS_HMETA = WS_WG + (size_t)2 * 2 * 16 * 256 * 128 * 2;
constexpr size_t WS_CARP = WS_HMETA + (size_t)NBATCH * NMETA * DM * 4;
constexpr size_t WS_CARH = WS_CARP + (size_t)GB * NCH * DI * 4;
constexpr size_t WS_SP = WS_CARH + (size_t)GB * NCH * DI * 4;
constexpr size_t WS_BAR = WS_SP + (size_t)4 * DI * 4;
constexpr size_t WS_ACT = (size_t)64 << 20;
static_assert(WS_BAR + 16384 <= WS_ACT, "weights region");
constexpr size_t A_Z = WS_ACT;
constexpr size_t A_ZP = A_Z + (size_t)RP * DM * 2;
constexpr size_t A_CQN = A_ZP + (size_t)RP * EINP * 2;
constexpr size_t A_CKVN = A_CQN + (size_t)RP * 384 * 2;
constexpr size_t A_Q = A_CKVN + (size_t)RP * 256 * 2;
constexpr size_t A_K = A_Q + (size_t)RP * 1536 * 2;
constexpr size_t A_V = A_K + (size_t)RP * 1536 * 2;
constexpr size_t A_END_E = A_V + (size_t)RP * 1024 * 2;
constexpr size_t A_XC = A_ZP + (size_t)RP * OIN * 2;
constexpr size_t A_LA = A_XC + (size_t)RP * DI * 2;
constexpr size_t A_BB = A_LA + (size_t)RP * DI * 2;
constexpr size_t A_END_O = A_BB + (size_t)RP * DI * 2;
constexpr size_t WS_NEED = A_END_E > A_END_O ? A_END_E : A_END_O;
static_assert(WS_NEED <= ((size_t)512 << 20), "workspace budget");

struct Params { const float* in[23]; float* out; unsigned char* ws; };
typedef const Params __attribute__((address_space(4)))* KP;

typedef unsigned short bf16_t;
typedef short bf16x8 __attribute__((ext_vector_type(8)));
typedef short s16x4 __attribute__((ext_vector_type(4)));
typedef float f32x4 __attribute__((ext_vector_type(4)));
typedef float f32x16 __attribute__((ext_vector_type(16)));
typedef unsigned u32x4 __attribute__((ext_vector_type(4)));
typedef unsigned u32x2 __attribute__((ext_vector_type(2)));
#define LAS __attribute__((address_space(3)))

__device__ __forceinline__ unsigned cvt_pk_bf16(float lo, float hi) { unsigned r; asm volatile("v_cvt_pk_bf16_f32 %0, %1, %2" : "=v"(r) : "v"(lo), "v"(hi)); return r; }
__device__ __forceinline__ float bf2f(unsigned short v) { return __uint_as_float((unsigned)v << 16); }
__device__ __forceinline__ float bflo(unsigned v) { return __uint_as_float(v << 16); }
__device__ __forceinline__ float bfhi(unsigned v) { return __uint_as_float(v & 0xffff0000u); }
__device__ __forceinline__ unsigned short f2bf(float f) { return (unsigned short)(cvt_pk_bf16(f, 0.f) & 0xffffu); }
typedef _Float16 h2_t __attribute__((ext_vector_type(2)));
__device__ __forceinline__ unsigned pk_h2(float a, float b) { h2_t v = {(_Float16)a, (_Float16)b}; return __builtin_bit_cast(unsigned, v); }
__device__ __forceinline__ float h2lo(unsigned u) { h2_t v = __builtin_bit_cast(h2_t, u); return (float)v[0]; }
__device__ __forceinline__ float h2hi(unsigned u) { h2_t v = __builtin_bit_cast(h2_t, u); return (float)v[1]; }
template <int CTRL> __device__ __forceinline__ float dppx(float v) { return __int_as_float(__builtin_amdgcn_update_dpp(0, __float_as_int(v), CTRL, 0xf, 0xf, false)); }
__device__ __forceinline__ float wave_sum(float v) {
    v += dppx<0xB1>(v); v += dppx<0x4E>(v); v += dppx<0x141>(v); v += dppx<0x140>(v);
    v += __int_as_float(__builtin_amdgcn_ds_swizzle(__float_as_int(v), 0x401F));
    auto rr = __builtin_amdgcn_permlane32_swap(__float_as_uint(v), __float_as_uint(v), false, false);
    return __uint_as_float(rr[0]) + __uint_as_float(rr[1]);
}
__device__ __forceinline__ int olane() { int l; asm volatile("v_mbcnt_lo_u32_b32 %0, -1, 0\n\tv_mbcnt_hi_u32_b32 %0, -1, %0" : "=v"(l)); return l; }
__device__ __forceinline__ int otid(int wv) { return wv * 64 + olane(); }
__device__ __forceinline__ int obid() { int b = blockIdx.x; asm volatile("" : "+s"(b)); return b; }
__device__ __forceinline__ float sigmoidf_(float x) { return __builtin_amdgcn_rcpf(1.f + __expf(-x)); }
__device__ __forceinline__ float siluf_(float x) { return x * __builtin_amdgcn_rcpf(1.f + __expf(-x)); }

__device__ __forceinline__ const float* h_src(KP p, int layer, int b, int t) {
    if (layer == 0) return t < NMETA ? p->in[1] + (size_t)t * DM : p->in[0] + ((size_t)b * SEQ + (t - NMETA)) * DM;
    return t < NMETA ? (const float*)(p->ws + WS_HMETA) + ((size_t)b * NMETA + t) * DM : p->out + ((size_t)b * SEQ + (t - NMETA)) * DM;
}
__device__ __forceinline__ float* h_dst(KP p, int b, int t) {
    return t < NMETA ? (float*)(p->ws + WS_HMETA) + ((size_t)b * NMETA + t) * DM : p->out + ((size_t)b * SEQ + (t - NMETA)) * DM;
}

namespace pg8 {
#define PG8_LAS __attribute__((address_space(3)))
typedef unsigned short bf16_t;
typedef short bf16x8 __attribute__((ext_vector_type(8)));
typedef float f32x4 __attribute__((ext_vector_type(4)));
typedef unsigned u32x4 __attribute__((ext_vector_type(4)));
constexpr int BM = 256, BK = 64, HALF = 128, HTB = HALF * BK * 2  , STAGE_BYTES = 8 * HTB, NXCD = 8, WGM = 8;

__host__ __device__ __forceinline__ int lds_byte(int r, int c) { const int st = (r >> 4) * 2 + (c >> 5), rr = r & 15, cc = c & 31, ob = rr * 64 + cc * 2; return st * 1024 + (ob ^ (((ob >> 9) & 1) << 5)); }
__host__ __device__ __forceinline__ void stage_rc(int b, int& R, int& C) { const int st = b / 1024, sb = b % 1024, swz = sb ^ (((sb >> 9) & 1) << 5); R = (st >> 1) * 16 + swz / 64; C = (st & 1) * 32 + (swz % 64) / 2; }
__host__ __device__ __forceinline__ int perm32(int rho) { const int n = rho >> 4, i = rho & 15; return 8 * (i >> 2) + 4 * n + (i & 3); }

struct Unit { int pm, pn; };
struct Gemm { const bf16_t* A; const bf16_t* Bt; };

struct StaticOrder {
    int nM, nN, nwg, G, c;
    __host__ __device__ void init(int M, int N, int G_, int c_) { nM = M / BM; nN = N / BM; nwg = nM * nN; G = G_; c = c_; }
    __host__ __device__ bool next(int i, Unit& u) const {
        const long L = (long)i * G + c; if (L >= nwg) return false;
        int wgid = (int)L; { const int q = nwg / NXCD, r = nwg % NXCD, xcd = wgid % NXCD, off = wgid / NXCD; wgid = (xcd < r ? xcd * (q + 1) : r * (q + 1) + (xcd - r) * q) + off; }
        const int nig = WGM * nN, gid = wgid / nig, fm = gid * WGM, gsz = (nM - fm) < WGM ? (nM - fm) : WGM;
        u.pm = fm + ((wgid % nig) % gsz); u.pn = (wgid % nig) / gsz; return true;
    }
    __device__ __forceinline__ void a_ready(const Unit&) const {}
    __device__ __forceinline__ void done(const Unit&) const {}
};
struct TailOrder {
    StaticOrder in; int nN, last;
    __host__ __device__ void init(int M, int N, int G_, int c_) { in.init(M - BM, N, G_, c_); nN = N / BM; last = M / BM - 1; }
    __host__ __device__ bool next(int i, Unit& u) const { if (in.next(i, u)) return true; const int L = i * in.G + in.c - in.nwg; if (L < nN) { u.pm = last; u.pn = L; return true; } return false; }
    __device__ __forceinline__ void a_ready(const Unit&) const {}
    __device__ __forceinline__ void done(const Unit&) const {}
};


struct EpiStore {
    static constexpr bool PERM = true, AFTER_DRAIN = false;
    bf16_t* O; int ldc;
    __device__ __forceinline__ void operator()(const f32x4 (&acc)[2][2][4][2], const Unit& u, int wr, int wc, int fr, int fq) const {
        const int row0 = u.pm * BM + wr * 64 + fr, col0 = u.pn * BM + wc * 32 + 8 * fq;
#pragma unroll
        for (int ai = 0; ai < 2; ++ai)
#pragma unroll
            for (int m = 0; m < 4; ++m) { bf16_t* rowp = O + (size_t)(row0 + ai * HALF + m * 16) * ldc + col0;
#pragma unroll
                for (int bj = 0; bj < 2; ++bj) { const f32x4 v0 = acc[ai][bj][m][0], v1 = acc[ai][bj][m][1];
                    u32x4 w; w.x = cvt_pk_bf16(v0[0], v0[1]); w.y = cvt_pk_bf16(v0[2], v0[3]); w.z = cvt_pk_bf16(v1[0], v1[1]); w.w = cvt_pk_bf16(v1[2], v1[3]);
                    *(u32x4*)(rowp + bj * HALF) = w; } }
    }
};
struct EpiKV {
    static constexpr bool PERM = true, AFTER_DRAIN = false;
    bf16_t* Kb; bf16_t* Vb;
    __device__ __forceinline__ void operator()(const f32x4 (&acc)[2][2][4][2], const Unit& u, int wr, int wc, int fr, int fq) const {
        const int row0 = u.pm * BM + wr * 64 + fr, d0 = wc * 32 + 8 * fq;
#pragma unroll
        for (int ai = 0; ai < 2; ++ai)
#pragma unroll
            for (int m = 0; m < 4; ++m) { const size_t row = (size_t)(row0 + ai * HALF + m * 16);
#pragma unroll
                for (int bj = 0; bj < 2; ++bj) { const f32x4 v0 = acc[ai][bj][m][0], v1 = acc[ai][bj][m][1];
                    u32x4 w; w.x = cvt_pk_bf16(v0[0], v0[1]); w.y = cvt_pk_bf16(v0[2], v0[3]); w.z = cvt_pk_bf16(v1[0], v1[1]); w.w = cvt_pk_bf16(v1[2], v1[3]);
                    bf16_t* dst = bj == 0 ? Kb + row * 1536 + u.pn * 192 + d0 : Vb + row * 1024 + u.pn * 128 + d0;
                    *(u32x4*)dst = w; } }
    }
};
struct EpiRes {
    static constexpr bool PERM = true, AFTER_DRAIN = false;
    const float* x; const float* meta; float* out; float* hmeta; int layer, g;
    __device__ __forceinline__ void operator()(const f32x4 (&acc)[2][2][4][2], const Unit& u, int wr, int wc, int fr, int fq) const {
        const int row0 = u.pm * BM + wr * 64 + fr, col0 = u.pn * BM + wc * 32 + 8 * fq;
#pragma unroll
        for (int ai = 0; ai < 2; ++ai)
#pragma unroll
            for (int m = 0; m < 4; ++m) { const int lr = row0 + ai * HALF + m * 16;
                if (lr < R) { const int bl = lr / T, t = lr - bl * T, b = g * GB + bl;
                    float* d; const float* s;
                    if (t < NMETA) { d = hmeta + ((size_t)b * NMETA + t) * DM; s = layer == 0 ? meta + (size_t)t * DM : d; }
                    else { const size_t o = ((size_t)b * SEQ + (t - NMETA)) * DM; d = out + o; s = layer == 0 ? x + o : d; }
#pragma unroll
                    for (int bj = 0; bj < 2; ++bj) { const int c = col0 + bj * HALF;
                        const f32x4 a0 = *(const f32x4*)(s + c), a1 = *(const f32x4*)(s + c + 4);
                        *(f32x4*)(d + c) = a0 + acc[ai][bj][m][0]; *(f32x4*)(d + c + 4) = a1 + acc[ai][bj][m][1]; } } }
    }
};
struct EpiGate {
    static constexpr bool PERM = true, AFTER_DRAIN = false;
    const bf16_t* xc; bf16_t* LA; bf16_t* BB; const float* b_a; const float* b_x; const float* lam;
    __device__ __forceinline__ void operator()(const f32x4 (&acc)[2][2][4][2], const Unit& u, int wr, int wc, int fr, int fq) const {
        const int row0 = u.pm * BM + wr * 64 + fr, ch0 = u.pn * 128 + wc * 32 + 8 * fq;
        float ba[8], bx[8], sp[8];
#pragma unroll
        for (int e = 0; e < 8; ++e) { ba[e] = b_a[ch0 + e]; bx[e] = b_x[ch0 + e]; sp[e] = lam[ch0 + e]; }
#pragma unroll
        for (int ai = 0; ai < 2; ++ai)
#pragma unroll
            for (int m = 0; m < 4; ++m) { const size_t row = (size_t)(row0 + ai * HALF + m * 16);
                if (u.pm * BM + wr * 64 + ai * HALF + m * 16 >= R) continue;
                const u32x4 xv = *(const u32x4*)(xc + row * DI + ch0);
                float la2[8], bb[8];
#pragma unroll
                for (int e = 0; e < 8; ++e) { const float ra = acc[ai][0][m][e >> 2][e & 3] + ba[e], ri = acc[ai][1][m][e >> 2][e & 3] + bx[e];
                    const float ea = 1.f + __expf(-ra), ei = 1.f + __expf(-ri), rc = __builtin_amdgcn_rcpf(ea * ei);
                    const float r = rc * ei, ig = rc * ea, l2 = -sp[e] * r;
                    const unsigned xw = xv[e >> 1]; const float xcv = (e & 1) ? bfhi(xw) : bflo(xw);
                    bb[e] = __builtin_amdgcn_sqrtf(fmaxf(1.0f - __builtin_amdgcn_exp2f(2.0f * l2), 0.f)) * ig * xcv; la2[e] = l2; }
                u32x4 w0, w1;
                w0.x = pk_h2(la2[0], la2[1]); w0.y = pk_h2(la2[2], la2[3]); w0.z = pk_h2(la2[4], la2[5]); w0.w = pk_h2(la2[6], la2[7]);
                w1.x = cvt_pk_bf16(bb[0], bb[1]); w1.y = cvt_pk_bf16(bb[2], bb[3]); w1.z = cvt_pk_bf16(bb[4], bb[5]); w1.w = cvt_pk_bf16(bb[6], bb[7]);
                *(u32x4*)(LA + row * DI + ch0) = w0; *(u32x4*)(BB + row * DI + ch0) = w1; }
    }
};

template <int LDA, int LDB, int KK, int APN, class Epi, class Sched, bool ALIGN_EPI = false, bool SP2 = false, int HALFPM = -1>
__device__ __forceinline__ void gemm_phase(PG8_LAS unsigned char* lds, const Gemm g, const Sched& S, const Epi& E, int wv) {
    const int tid = otid(wv), wid = wv, lane = tid & 63, wr = wid >> 2, wc = wid & 3, fr = lane & 15, fq = lane >> 4;
    constexpr int K = KK; int nt = K / BK; asm volatile("" : "+s"(nt));
    unsigned voffA[2], voffB[2];
#pragma unroll
    for (int i = 0; i < 2; ++i) { int R, C; stage_rc(tid * 16 + i * 8192, R, C); const int Rb = Epi::PERM ? ((R & ~31) + perm32(R & 31)) : R;
        voffA[i] = (unsigned)(R * LDA + C) * 2u; voffB[i] = (unsigned)(Rb * LDB + C) * 2u; }
    constexpr size_t kstep = (size_t)(BK * 2);
    constexpr size_t hstepA = (size_t)HALF * LDA * 2, hstepB = (size_t)HALF * LDB * 2;
    constexpr size_t tstepA = 2 * hstepA, tstepB = 2 * hstepB, apn = (size_t)APN * 2;
    const unsigned ldsw = (unsigned)wid * 1024u;
    const int aoff = lds_byte(wr * 64 + fr, fq * 8), boff = lds_byte(wc * 32 + fr, fq * 8);
#define PG8_SA(b, h) (((b) * 2 + (h)) * HTB)
#define PG8_SB(b, h) ((4 + (b) * 2 + (h)) * HTB)
#define PG8_STAGE(bufoff, gbase, voff) do { _Pragma("unroll") for (int _i = 0; _i < 2; ++_i) \
        __builtin_amdgcn_global_load_lds((const unsigned*)((const char*)(gbase) + (voff)[_i]), (PG8_LAS unsigned*)(lds + (bufoff) + ldsw + _i * 8192), 16, 0, 0); } while (0)
#define PG8_LDA(dst, b, h) do { _Pragma("unroll") for (int m = 0; m < 4; ++m) _Pragma("unroll") for (int k = 0; k < 2; ++k) dst[m][k] = *(const PG8_LAS bf16x8*)(lds + PG8_SA(b, h) + aoff + m * 2048 + k * 1024); } while (0)
#define PG8_LDB(dst, b, h) do { _Pragma("unroll") for (int n = 0; n < 2; ++n) _Pragma("unroll") for (int k = 0; k < 2; ++k) dst[n][k] = *(const PG8_LAS bf16x8*)(lds + PG8_SB(b, h) + boff + n * 2048 + k * 1024); } while (0)
#define PG8_MMA(ai, bj, At, Bt) do { __builtin_amdgcn_s_setprio(1); _Pragma("unroll") for (int m = 0; m < 4; ++m) _Pragma("unroll") for (int n = 0; n < 2; ++n) _Pragma("unroll") for (int k = 0; k < 2; ++k) \
        acc[ai][bj][m][n] = __builtin_amdgcn_mfma_f32_16x16x32_bf16(Bt[n][k], At[m][k], acc[ai][bj][m][n], 0, 0, 0); __builtin_amdgcn_s_setprio(0); } while (0)
#define PG8_WAIT_V(n) asm volatile("s_waitcnt vmcnt(" #n ")" ::: "memory")
#define PG8_WAIT_L(n) asm volatile("s_waitcnt lgkmcnt(" #n ")" ::: "memory")
#define PG8_BAR __builtin_amdgcn_s_barrier()
#define PG8_SCHED __builtin_amdgcn_sched_barrier(0)
    Unit cur, nxt; int ui = 0;
    if (!S.next(0, cur)) return;
    f32x4 acc[2][2][4][2];
#pragma unroll
    for (int a = 0; a < 2; ++a)
#pragma unroll
        for (int b = 0; b < 2; ++b)
#pragma unroll
            for (int m = 0; m < 4; ++m)
#pragma unroll
                for (int n = 0; n < 2; ++n) { f32x4 z_ = {0.f, 0.f, 0.f, 0.f}; asm volatile("" : "+v"(z_)); acc[a][b][m][n] = z_; }
    bf16x8 At[4][2], B0[2][2], B1[2][2];
    const char* cA = (const char*)g.A + (size_t)cur.pm * tstepA + (size_t)cur.pn * apn; const char* cB = (const char*)g.Bt + (size_t)cur.pn * tstepB;
    S.a_ready(cur);
    if constexpr (SP2) {
        PG8_STAGE(PG8_SB(0, 0), cB, voffB); PG8_STAGE(PG8_SB(0, 1), cB + hstepB, voffB); PG8_STAGE(PG8_SA(0, 0), cA, voffA); PG8_STAGE(PG8_SA(0, 1), cA + hstepA, voffA);
        if (wr == 1) PG8_BAR;
        PG8_WAIT_V(2); PG8_BAR;
        PG8_STAGE(PG8_SB(1, 0), cB + kstep, voffB); PG8_STAGE(PG8_SA(1, 0), cA + kstep, voffA); PG8_STAGE(PG8_SB(1, 1), cB + hstepB + kstep, voffB);
        PG8_WAIT_V(6); PG8_BAR;
    } else {
        PG8_STAGE(PG8_SB(0, 0), cB, voffB); PG8_STAGE(PG8_SA(0, 0), cA, voffA); PG8_STAGE(PG8_SB(0, 1), cB + hstepB, voffB); PG8_STAGE(PG8_SA(0, 1), cA + hstepA, voffA);
        if (wr == 1) PG8_BAR;
        PG8_WAIT_V(4); PG8_BAR;
        PG8_STAGE(PG8_SB(1, 0), cB + kstep, voffB); PG8_STAGE(PG8_SA(1, 0), cA + kstep, voffA); PG8_STAGE(PG8_SB(1, 1), cB + hstepB + kstep, voffB);
        PG8_WAIT_V(6); PG8_BAR;
    }
    for (;;) {
        const bool has_next = S.next(ui + 1, nxt);
        const char* nA = has_next ? (const char*)g.A + (size_t)nxt.pm * tstepA + (size_t)nxt.pn * apn : cA; const char* nB = has_next ? (const char*)g.Bt + (size_t)nxt.pn * tstepB : cB;
#pragma clang loop unroll(disable)
        for (int t = 0; t < nt; t += 2) {
            const bool last = (t == nt - 2);
            const char* a1 = cA + (size_t)(t + 1) * kstep;
            const char* a2 = last ? nA : cA + (size_t)(t + 2) * kstep; const char* b2 = last ? nB : cB + (size_t)(t + 2) * kstep;
            const char* a3 = a2 + kstep; const char* b3 = b2 + kstep;
            if (last && has_next) S.a_ready(nxt);
            if constexpr (SP2) {
            PG8_LDB(B0, 0, 0); PG8_LDB(B1, 0, 1); PG8_SCHED; PG8_LDA(At, 0, 0); PG8_STAGE(PG8_SA(1, 1), a1 + hstepA, voffA);
            PG8_WAIT_V(8); PG8_WAIT_L(0); PG8_BAR; PG8_MMA(0, 0, At, B0); PG8_MMA(0, 1, At, B1); PG8_BAR; PG8_SCHED;
            PG8_LDA(At, 0, 1); PG8_STAGE(PG8_SB(0, 0), b2, voffB); PG8_STAGE(PG8_SB(0, 1), b2 + hstepB, voffB); PG8_STAGE(PG8_SA(0, 0), a2, voffA);
            PG8_WAIT_V(8); PG8_WAIT_L(0); PG8_BAR; if (HALFPM < 0 || cur.pm != HALFPM) { PG8_MMA(1, 0, At, B0); PG8_MMA(1, 1, At, B1); } PG8_BAR; PG8_SCHED;
            PG8_LDB(B0, 1, 0); PG8_LDB(B1, 1, 1); PG8_SCHED; PG8_LDA(At, 1, 0); PG8_STAGE(PG8_SA(0, 1), a2 + hstepA, voffA);
            PG8_WAIT_V(8); PG8_WAIT_L(0); PG8_BAR; PG8_MMA(0, 0, At, B0); PG8_MMA(0, 1, At, B1); PG8_BAR; PG8_SCHED;
            PG8_LDA(At, 1, 1); PG8_STAGE(PG8_SB(1, 0), b3, voffB); PG8_STAGE(PG8_SB(1, 1), b3 + hstepB, voffB); PG8_STAGE(PG8_SA(1, 0), a3, voffA);
            PG8_WAIT_V(8); PG8_WAIT_L(0); PG8_BAR; if (HALFPM < 0 || cur.pm != HALFPM) { PG8_MMA(1, 0, At, B0); PG8_MMA(1, 1, At, B1); } PG8_BAR; PG8_SCHED;
            } else {
            PG8_LDB(B0, 0, 0); PG8_SCHED; PG8_LDA(At, 0, 0); PG8_STAGE(PG8_SA(1, 1), a1 + hstepA, voffA);
            PG8_WAIT_L(8); PG8_BAR; PG8_WAIT_L(0); PG8_MMA(0, 0, At, B0); PG8_BAR; PG8_SCHED;
            PG8_LDB(B1, 0, 1); PG8_STAGE(PG8_SB(0, 0), b2, voffB);
            PG8_BAR; PG8_WAIT_L(0); PG8_MMA(0, 1, At, B1); PG8_BAR;
            PG8_LDA(At, 0, 1); PG8_STAGE(PG8_SA(0, 0), a2, voffA);
            PG8_BAR; PG8_WAIT_L(0); PG8_MMA(1, 0, At, B0); PG8_BAR; PG8_SCHED;
            PG8_STAGE(PG8_SB(0, 1), b2 + hstepB, voffB);
            PG8_WAIT_V(6); PG8_BAR; PG8_MMA(1, 1, At, B1); PG8_BAR;
            PG8_LDB(B0, 1, 0); PG8_SCHED; PG8_LDA(At, 1, 0); PG8_STAGE(PG8_SA(0, 1), a2 + hstepA, voffA);
            PG8_WAIT_L(8); PG8_BAR; PG8_WAIT_L(0); PG8_MMA(0, 0, At, B0); PG8_BAR; PG8_SCHED;
            PG8_LDB(B1, 1, 1); PG8_STAGE(PG8_SB(1, 0), b3, voffB);
            PG8_BAR; PG8_WAIT_L(0); PG8_MMA(0, 1, At, B1); PG8_BAR;
            PG8_LDA(At, 1, 1); PG8_STAGE(PG8_SA(1, 0), a3, voffA);
            PG8_BAR; PG8_WAIT_L(0); PG8_MMA(1, 0, At, B0); PG8_BAR; PG8_SCHED;
            PG8_STAGE(PG8_SB(1, 1), b3 + hstepB, voffB);
            PG8_WAIT_V(6); PG8_BAR; PG8_MMA(1, 1, At, B1); PG8_BAR;
            }
        }
        if constexpr (ALIGN_EPI) { if (wr == 0) PG8_BAR; }
        if constexpr (!Epi::AFTER_DRAIN) { E(acc, cur, wr, wc, fr, fq); S.done(cur); }
        if (!has_next) break;
#pragma unroll
        for (int a = 0; a < 2; ++a)
#pragma unroll
            for (int b = 0; b < 2; ++b)
#pragma unroll
                for (int m = 0; m < 4; ++m)
#pragma unroll
                    for (int n = 0; n < 2; ++n) { f32x4 z_ = {0.f, 0.f, 0.f, 0.f}; asm volatile("" : "+v"(z_)); acc[a][b][m][n] = z_; }
        cur = nxt; cA = nA; cB = nB; ++ui;
        if constexpr (ALIGN_EPI) { if (wr == 1) PG8_BAR; }
    }
    PG8_WAIT_V(0);
    if constexpr (!ALIGN_EPI) { if (wr == 0) PG8_BAR; }
    PG8_BAR;
    if constexpr (Epi::AFTER_DRAIN) { E.fused(acc, cur, wr, wc, fr, fq, lds, wid, lane); S.done(cur); }
#undef PG8_SA
#undef PG8_SB
#undef PG8_STAGE
#undef PG8_LDA
#undef PG8_LDB
#undef PG8_MMA
#undef PG8_WAIT_V
#undef PG8_WAIT_L
#undef PG8_BAR
#undef PG8_SCHED
}
}

namespace att {
constexpr int NW = 8, QBLK = 32, KVBLK = 64;
constexpr float THR = 8.f;
#define SBAR() __builtin_amdgcn_sched_barrier(0)
__device__ __forceinline__ int crow(int r, int hi) { return (r & 3) + 8 * (r >> 2) + 4 * hi; }
__device__ __forceinline__ unsigned cvtpk(float lo, float hi) { unsigned r; asm volatile("v_cvt_pk_bf16_f32 %0, %1, %2" : "=v"(r) : "v"(lo), "v"(hi)); return r; }

template <int DQK> struct Cfg {
    static constexpr float SCALE = DQK == 192 ? 0.07216878364870322f : 0.08838834764831845f;
    static constexpr int KROWB = DQK * 2, SHM_V = KVBLK * 128 * 2, SHM_K = KVBLK * DQK * 2, KC = DQK / 64, ND0 = DQK / 16;
    static constexpr int NKA = DQK == 128 ? 1 : 4;
    static __device__ __forceinline__ int fsw(int r) { return DQK == 128 ? (r & 15) : ((r >> 1) & 7); }
    static constexpr int OFF_K = 3 * SHM_V, OFF_WS = 3 * SHM_V + 2 * SHM_K, LDS_NEED = OFF_WS + NW * 64 * 4;
};

template <int DQK>
__device__ __forceinline__ void partialSM(f32x16& p0, f32x16& p1, float& m_reg, float& mn, float& alpha) {
    constexpr float SCALE = Cfg<DQK>::SCALE, C = SCALE * 1.4426950408889634f;
    float pmax = p0[0];
#pragma unroll
    for (int r = 1; r < 16; ++r) pmax = fmaxf(pmax, p0[r]);
#pragma unroll
    for (int r = 0; r < 16; ++r) pmax = fmaxf(pmax, p1[r]);
    { auto rr = __builtin_amdgcn_permlane32_swap(__float_as_uint(pmax), __float_as_uint(pmax), false, false);
      pmax = fmaxf(__uint_as_float(rr[0]), __uint_as_float(rr[1])); }
    if (__builtin_expect(__all(pmax - m_reg <= THR / SCALE), 1)) { mn = m_reg; alpha = 1.f; }
    else { mn = fmaxf(m_reg, pmax); alpha = __builtin_amdgcn_exp2f((m_reg - mn) * C); m_reg = mn; }
    const float mnC = -mn * C;
#pragma unroll
    for (int r = 0; r < 16; ++r) p0[r] = fmaf(p0[r], C, mnC);
#pragma unroll
    for (int r = 0; r < 16; ++r) p1[r] = fmaf(p1[r], C, mnC);
#pragma unroll
    for (int r = 0; r < 16; ++r) p0[r] = __builtin_amdgcn_exp2f(p0[r]);
}
__device__ __forceinline__ void finishSM(f32x16& p0, f32x16& p1, float alpha, float& l_reg, bf16x8& pa0, bf16x8& pa1, bf16x8& pa2, bf16x8& pa3) {
#pragma unroll
    for (int r = 0; r < 16; ++r) p1[r] = __builtin_amdgcn_exp2f(p1[r]);
    float ps = 0;
#pragma unroll
    for (int r = 0; r < 16; ++r) ps += p0[r];
#pragma unroll
    for (int r = 0; r < 16; ++r) ps += p1[r];
    { auto rr = __builtin_amdgcn_permlane32_swap(__float_as_uint(ps), __float_as_uint(ps), false, false);
      ps = __uint_as_float(rr[0]) + __uint_as_float(rr[1]); }
    l_reg = l_reg * alpha + ps;
#define PK4(P, BASE, OUT) do { unsigned a0 = cvtpk(P[BASE + 0], P[BASE + 1]), a1 = cvtpk(P[BASE + 2], P[BASE + 3]);   \
    unsigned b0 = cvtpk(P[BASE + 4], P[BASE + 5]), b1 = cvtpk(P[BASE + 6], P[BASE + 7]);                              \
    auto r0 = __builtin_amdgcn_permlane32_swap(a0, b0, false, false); auto r1 = __builtin_amdgcn_permlane32_swap(a1, b1, false, false); \
    u32x4 w = {r0[0], r1[0], r0[1], r1[1]}; OUT = *reinterpret_cast<bf16x8*>(&w); } while (0)
    PK4(p0, 0, pa0); PK4(p0, 8, pa1); PK4(p1, 0, pa2); PK4(p1, 8, pa3);
#undef PK4
}
template <int DQK>
__device__ __forceinline__ void qkt(f32x16& p0, f32x16& p1, const char* Ks, const bf16x8* qr, const int (&ka)[Cfg<DQK>::NKA], int r32) {
    constexpr int KROWB = Cfg<DQK>::KROWB;
    { f32x16 z = {}; asm volatile("" : "+v"(z)); p0 = z; p1 = z; }
    int kf = DQK == 128 ? (r32 & 14) : 0; if (DQK == 128) asm volatile("" : "+v"(kf));
#define KOFF(d0_) (DQK == 128 ? ka[0] + (((2 * (d0_)) ^ kf) << 4) : ka[(d0_) & 3] + ((d0_) >> 2) * 128)
    bf16x8 c0 = *reinterpret_cast<const bf16x8*>(Ks + KOFF(0)), c1 = *reinterpret_cast<const bf16x8*>(Ks + KOFF(0) + 32 * KROWB);
#pragma unroll
    for (int d0 = 0; d0 < Cfg<DQK>::ND0; ++d0) {
        bf16x8 n0 = c0, n1 = c1;
        if (d0 + 1 < Cfg<DQK>::ND0) { n0 = *reinterpret_cast<const bf16x8*>(Ks + KOFF(d0 + 1)); n1 = *reinterpret_cast<const bf16x8*>(Ks + KOFF(d0 + 1) + 32 * KROWB); }
        p0 = __builtin_amdgcn_mfma_f32_32x32x16_bf16(c0, qr[d0], p0, 0, 0, 0);
        p1 = __builtin_amdgcn_mfma_f32_32x32x16_bf16(c1, qr[d0], p1, 0, 0, 0);
        c0 = n0; c1 = n1; }
#undef KOFF
}
__device__ __forceinline__ int v_st(int k, int c) { const int kk = (k & ~0xC) | ((k & 4) << 1) | ((k & 8) >> 1); return ((kk >> 3) * 4 + (c >> 5)) * 512 + ((kk & 7) * 32 + (c & 31)) * 2; }
__device__ __forceinline__ int v_rd_base(int lane) { return ((lane & 3) << 3) | (((lane >> 2) & 3) << 6) | (((lane >> 4) & 1) << 5) | (((lane >> 5) & 1) << 8); }
constexpr int v_rd_off(int d0, int ks, int half) { return d0 * 512 + ks * 4096 + half * 2048; }
template <int OFF> __device__ __forceinline__ s16x4 tr_read(int vb) {
    s16x4 r; asm volatile("ds_read_b64_tr_b16 %0, %1 offset:%2" : "=&v"(r) : "v"(vb), "i"(OFF) : "memory"); return r;
}
template <int D0> __device__ __forceinline__ void pv_one(f32x16& od, int vb, bf16x8 pa0, bf16x8 pa1, bf16x8 pa2, bf16x8 pa3) {
    const s16x4 l0 = tr_read<v_rd_off(D0, 0, 0)>(vb), h0 = tr_read<v_rd_off(D0, 0, 1)>(vb), l1 = tr_read<v_rd_off(D0, 1, 0)>(vb), h1 = tr_read<v_rd_off(D0, 1, 1)>(vb);
    const s16x4 l2 = tr_read<v_rd_off(D0, 2, 0)>(vb), h2 = tr_read<v_rd_off(D0, 2, 1)>(vb), l3 = tr_read<v_rd_off(D0, 3, 0)>(vb), h3 = tr_read<v_rd_off(D0, 3, 1)>(vb);
    asm volatile("s_waitcnt lgkmcnt(0)" ::: "memory"); SBAR();
#define PK(L, H) (bf16x8){L[0], L[1], L[2], L[3], H[0], H[1], H[2], H[3]}
    od = __builtin_amdgcn_mfma_f32_32x32x16_bf16(pa0, PK(l0, h0), od, 0, 0, 0);
    od = __builtin_amdgcn_mfma_f32_32x32x16_bf16(pa1, PK(l1, h1), od, 0, 0, 0);
    od = __builtin_amdgcn_mfma_f32_32x32x16_bf16(pa2, PK(l2, h2), od, 0, 0, 0);
    od = __builtin_amdgcn_mfma_f32_32x32x16_bf16(pa3, PK(l3, h3), od, 0, 0, 0);
#undef PK
}
__device__ __forceinline__ void pv_d0(f32x16* o, int vb, bf16x8 pa0, bf16x8 pa1, bf16x8 pa2, bf16x8 pa3) {
    pv_one<0>(o[0], vb, pa0, pa1, pa2, pa3); pv_one<1>(o[1], vb, pa0, pa1, pa2, pa3); pv_one<2>(o[2], vb, pa0, pa1, pa2, pa3); pv_one<3>(o[3], vb, pa0, pa1, pa2, pa3);
}
template <bool SWA>
__device__ __forceinline__ void mask_tile(f32x16& p0, f32x16& p1, int k0, int klo, int tq, int hi) {
#pragma unroll
    for (int r = 0; r < 16; ++r) {
        const int tk0 = k0 + crow(r, hi), tk1 = tk0 + 32;
        bool ok0 = tk0 >= klo, ok1 = tk1 >= klo;
        if (SWA) { const int d0 = tq - tk0, d1 = tq - tk1;
            ok0 = ok0 && (tk0 < NMETA || (d0 <= 128 && d0 >= -128)); ok1 = ok1 && (tk1 < NMETA || (d1 <= 128 && d1 >= -128)); }
        if (!ok0) p0[r] = -1e30f;
        if (!ok1) p1[r] = -1e30f;
    }
}

template <int DQK, int LDQ, int LDK, int LDV, bool SWA>
__device__ __forceinline__ void attn_unit(const bf16_t* __restrict__ Qb, const bf16_t* __restrict__ Kh, const bf16_t* __restrict__ Vh, bf16_t* Yg,
                                          int i0, int NT, int tfirst, float m_init, float l_init, char* lds, LAS unsigned char* ldsl, int wv, bool dostore, const float* gq) {
    using C = Cfg<DQK>;
    constexpr int SHM_V = C::SHM_V, SHM_K = C::SHM_K, KC = C::KC, KROWB = C::KROWB;
    const int tid = otid(wv), wid = wv, lane = tid & 63, r32 = lane & 31, hi = lane >> 5;
    char* V_lds = lds; char* K_lds = lds + C::OFF_K;
    float* wsp = (float*)(lds + C::OFF_WS) + wid * 64; float* li_l = wsp; float* al_l = wsp + 32;
    float m_reg = m_init, l_reg = l_init; f32x16 o[4]; bf16x8 qr[C::ND0];
#pragma unroll
    for (int d = 0; d < 4; ++d) { f32x16 z_ = {}; asm volatile("" : "+v"(z_)); o[d] = z_; }
    const int tq = i0 + wid * QBLK + r32;
    const bool wactive = i0 + wid * QBLK < T;
    { const int tqc = tq < T ? tq : T - 1; const bf16_t* Qw = Qb + (size_t)tqc * LDQ + hi * 8;
#pragma unroll
      for (int d0 = 0; d0 < C::ND0; ++d0) qr[d0] = *reinterpret_cast<const bf16x8*>(Qw + d0 * 16); }
    if constexpr (!SWA) {
        const int tqc = tq < T ? tq : T - 1;
        float ss = 0.f;
#pragma unroll
        for (int d0 = 0; d0 < C::ND0; ++d0) { const u32x4 w = __builtin_bit_cast(u32x4, qr[d0]);
#pragma unroll
            for (int e = 0; e < 4; ++e) { const float a = bflo(w[e]), b = bfhi(w[e]); ss += a * a + b * b; } }
        { auto rr = __builtin_amdgcn_permlane32_swap(__float_as_uint(ss), __float_as_uint(ss), false, false); ss = __uint_as_float(rr[0]) + __uint_as_float(rr[1]); }
        const float rstd = rsqrtf(ss * (1.f / 192.f) + EPS);
#pragma unroll
        for (int d0 = 0; d0 < 8; ++d0) { const u32x4 w = __builtin_bit_cast(u32x4, qr[d0]); const f32x4 g0 = *(const f32x4*)(gq + d0 * 16 + hi * 8), g1 = *(const f32x4*)(gq + d0 * 16 + hi * 8 + 4);
            u32x4 o_; o_[0] = cvtpk(bflo(w[0]) * rstd * g0[0], bfhi(w[0]) * rstd * g0[1]); o_[1] = cvtpk(bflo(w[1]) * rstd * g0[2], bfhi(w[1]) * rstd * g0[3]);
            o_[2] = cvtpk(bflo(w[2]) * rstd * g1[0], bfhi(w[2]) * rstd * g1[1]); o_[3] = cvtpk(bflo(w[3]) * rstd * g1[2], bfhi(w[3]) * rstd * g1[3]);
            qr[d0] = __builtin_bit_cast(bf16x8, o_); }
#pragma unroll
        for (int dd = 0; dd < 2; ++dd) { const u32x4 w1 = __builtin_bit_cast(u32x4, qr[8 + dd]), w2 = __builtin_bit_cast(u32x4, qr[10 + dd]);
            float y1[8], y2[8];
#pragma unroll
            for (int e = 0; e < 8; ++e) { const int ci = dd * 16 + hi * 8 + e;
                const float x1 = (e & 1) ? bfhi(w1[e >> 1]) : bflo(w1[e >> 1]), x2 = (e & 1) ? bfhi(w2[e >> 1]) : bflo(w2[e >> 1]);
                const float a1 = x1 * rstd * gq[128 + ci], a2 = x2 * rstd * gq[160 + ci];
                float sn, cs; sincosf((float)tqc * exp2f(-(float)(2 * ci) * (13.287712379549449f / 64.f)), &sn, &cs);
                y1[e] = a1 * cs - a2 * sn; y2[e] = a1 * sn + a2 * cs; }
            u32x4 o1, o2;
#pragma unroll
            for (int e = 0; e < 4; ++e) { o1[e] = cvtpk(y1[2 * e], y1[2 * e + 1]); o2[e] = cvtpk(y2[2 * e], y2[2 * e + 1]); }
            qr[8 + dd] = __builtin_bit_cast(bf16x8, o1); qr[10 + dd] = __builtin_bit_cast(bf16x8, o2); }
    }
    unsigned koff[KC], voff[2];
#pragma unroll
    for (int i = 0; i < KC; ++i) { const int c = (wid * KC + i) * 64 + lane, row = c / (DQK / 8), pos = c % (DQK / 8); koff[i] = (unsigned)(row * LDK + (pos ^ C::fsw(row)) * 8); }
#pragma unroll
    for (int i = 0; i < 2; ++i) { const int o16 = ((wid * 2 + i) * 64 + lane) * 16, sub = o16 >> 9, within = o16 & 511, kk = (sub >> 2) * 8 + (within >> 6);
        const int vr = (kk & ~0xC) | ((kk & 4) << 1) | ((kk & 8) >> 1); voff[i] = (unsigned)(vr * LDV + (sub & 3) * 32 + ((within & 63) >> 1)); }
    int ka[C::NKA];
#pragma unroll
    for (int q4 = 0; q4 < C::NKA; ++q4) ka[q4] = r32 * KROWB + ((q4 * 32 + hi * 16) ^ (C::fsw(r32) << 4));
    if (DQK == 128) ka[0] = r32 * KROWB + ((hi ^ (r32 & 1)) << 4);
    const int vb0 = (int)(uintptr_t)V_lds + v_rd_base(lane);
    const bool hasmeta = SWA && tfirst > 0;
#define TKOFF(j) (SWA ? ((hasmeta && (j) == 0) ? 0 : (tfirst + (j) - (hasmeta ? 1 : 0)) * KVBLK) : (j) * KVBLK)
#define KA(j) (TKOFF(j) < T - KVBLK ? TKOFF(j) : T - KVBLK)
#define DMA(j_, ks_, vs_) do { const int k0__ = KA(j_); const bf16_t* kt_ = Kh + (size_t)k0__ * LDK; const bf16_t* vt_ = Vh + (size_t)k0__ * LDV; \
    _Pragma("unroll") for (int i = 0; i < KC; ++i) \
        __builtin_amdgcn_global_load_lds((const unsigned*)(kt_ + koff[i]), (LAS unsigned*)(ldsl + C::OFF_K + (ks_) * SHM_K + (wid * KC + i) * 1024), 16, 0, 0); \
    _Pragma("unroll") for (int i = 0; i < 2; ++i) \
        __builtin_amdgcn_global_load_lds((const unsigned*)(vt_ + voff[i]), (LAS unsigned*)(ldsl + (vs_) * SHM_V + (wid * 2 + i) * 1024), 16, 0, 0); } while (0)
#define LANDED() do { asm volatile("s_waitcnt vmcnt(0)" ::: "memory"); __syncthreads(); } while (0)
#define RESC(a) do { if (__any((a) < 1.f)) { if (hi == 0) al_l[r32] = (a); asm volatile("s_waitcnt lgkmcnt(0)" ::: "memory"); \
    _Pragma("unroll") for (int d = 0; d < 4; ++d) _Pragma("unroll") for (int r = 0; r < 16; ++r) o[d][r] *= al_l[crow(r, hi)]; } } while (0)
#define MASK(P0, P1, j) do { const int k0m = TKOFF(j); if (SWA || k0m + KVBLK > T) { int hi_ = hi; asm volatile("" : "+v"(hi_)); mask_tile<SWA>(P0, P1, KA(j), k0m, tq, hi_); } } while (0)
    f32x16 pA0, pA1, pB0, pB1; float mnA, mnB, alA, alB; bf16x8 pa0, pa1, pa2, pa3;
    if constexpr (SWA) {
        const int w0 = i0 + wid * QBLK;
        DMA(0, 0, 0); LANDED();
        for (int j = 0; j < NT; ++j) {
            const int sl = j & 1, k0n = TKOFF(j);
            if (j + 1 < NT) DMA(j + 1, sl ^ 1, sl ^ 1);
            if (wactive && (k0n == 0 || (k0n + KVBLK > w0 - 128 && k0n <= w0 + QBLK - 1 + 128))) {
                SBAR(); qkt<DQK>(pA0, pA1, K_lds + sl * SHM_K, qr, ka, r32);
                MASK(pA0, pA1, j); partialSM<DQK>(pA0, pA1, m_reg, mnA, alA);
                RESC(alA);
                finishSM(pA0, pA1, alA, l_reg, pa0, pa1, pa2, pa3); SBAR();
                pv_d0(o, vb0 + sl * SHM_V, pa0, pa1, pa2, pa3); }
            LANDED();
        }
    } else {
    DMA(0, 0, 0); LANDED();
    DMA(1, 1, 1);
    if (wactive) { qkt<DQK>(pA0, pA1, K_lds, qr, ka, r32); MASK(pA0, pA1, 0); partialSM<DQK>(pA0, pA1, m_reg, mnA, alA); }
    LANDED();
    int vprev = 0, vnext = 2;
    for (int j = 1; j + 1 < NT; j += 2) {
        DMA(j + 1, 0, vnext);
        if (wactive) { SBAR(); qkt<DQK>(pB0, pB1, K_lds + SHM_K, qr, ka, r32);
            finishSM(pA0, pA1, alA, l_reg, pa0, pa1, pa2, pa3); SBAR();
            pv_d0(o, vb0 + vprev * SHM_V, pa0, pa1, pa2, pa3); MASK(pB0, pB1, j); partialSM<DQK>(pB0, pB1, m_reg, mnB, alB);
            RESC(alB); }
        LANDED();
        vprev = vprev == 2 ? 0 : vprev + 1; vnext = vnext == 2 ? 0 : vnext + 1;
        DMA(j + 2, 1, vnext);
        if (wactive) { SBAR(); qkt<DQK>(pA0, pA1, K_lds, qr, ka, r32);
            finishSM(pB0, pB1, alB, l_reg, pa0, pa1, pa2, pa3); SBAR();
            pv_d0(o, vb0 + vprev * SHM_V, pa0, pa1, pa2, pa3); MASK(pA0, pA1, j + 1); partialSM<DQK>(pA0, pA1, m_reg, mnA, alA);
            RESC(alA); }
        LANDED();
        vprev = vprev == 2 ? 0 : vprev + 1; vnext = vnext == 2 ? 0 : vnext + 1;
    }
    if (wactive) {
        const int vb0t = (int)(uintptr_t)V_lds + v_rd_base(olane());
        SBAR(); qkt<DQK>(pB0, pB1, K_lds + SHM_K, qr, ka, r32);
        finishSM(pA0, pA1, alA, l_reg, pa0, pa1, pa2, pa3); SBAR();
        pv_d0(o, vb0t + vprev * SHM_V, pa0, pa1, pa2, pa3); MASK(pB0, pB1, NT - 1); partialSM<DQK>(pB0, pB1, m_reg, mnB, alB);
        RESC(alB);
        vprev = vprev == 2 ? 0 : vprev + 1;
        finishSM(pB0, pB1, alB, l_reg, pa0, pa1, pa2, pa3); SBAR();
        pv_d0(o, vb0t + vprev * SHM_V, pa0, pa1, pa2, pa3);
    }
    }
    if (hi == 0) li_l[r32] = l_reg; asm volatile("s_waitcnt lgkmcnt(0)" ::: "memory");
    const int le = olane(), r32e = le & 31, hie = le >> 5;
    float rli[16]; { const float* lib = li_l + 4 * hie;
#pragma unroll
    for (int r = 0; r < 16; ++r) rli[r] = __builtin_amdgcn_rcpf(lib[(r & 3) + 8 * (r >> 2)]); }
    __syncthreads();
    {
      bf16_t* stg = (bf16_t*)(lds + wid * (32 * 136 * 2)); bf16_t* stw = stg + hie * 4 * 136 + r32e;
#pragma unroll
      for (int r = 0; r < 16; ++r) { const int rowc = (r & 3) + 8 * (r >> 2);
#pragma unroll
          for (int d0 = 0; d0 < 4; ++d0) stw[rowc * 136 + d0 * 32] = f2bf(o[d0][r] * rli[r]); }
      asm volatile("s_waitcnt lgkmcnt(0)" ::: "memory");
#pragma unroll 1
      for (int half = 0; half < 2; ++half) {
          u32x4 gv[4], ov[4];
#pragma unroll
          for (int i4 = 0; i4 < 4; ++i4) { const int idx = (half * 4 + i4) * 64 + le, row = idx >> 4, c8 = (idx & 15) * 8, trow = i0 + wid * QBLK + row;
              ov[i4] = *(const u32x4*)(stg + row * 136 + c8);
              gv[i4] = (trow < T && dostore) ? *(const u32x4*)(Yg + (size_t)trow * EINP + c8) : (u32x4){0u, 0u, 0u, 0u}; }
#pragma unroll
          for (int i4 = 0; i4 < 4; ++i4) { const int idx = (half * 4 + i4) * 64 + le, row = idx >> 4, c8 = (idx & 15) * 8, trow = i0 + wid * QBLK + row;
              if (trow < T && dostore) { u32x4 w;
#pragma unroll
                  for (int e = 0; e < 4; ++e) w[e] = cvt_pk_bf16(bflo(ov[i4][e]) * siluf_(bflo(gv[i4][e])), bfhi(ov[i4][e]) * siluf_(bfhi(gv[i4][e])));
                  *(u32x4*)(Yg + (size_t)trow * EINP + c8) = w; } } } }
    __syncthreads();
#undef TKOFF
#undef KA
#undef DMA
#undef LANDED
#undef RESC
#undef MASK
}
}

__device__ __forceinline__ void xpose_item(const float* W, int K, int N, bf16_t* WT, float* scr, int item, int lane) {
    const int nblk = N / 32, kb = item / nblk, nb = item % nblk, k0 = 64 * kb, n0 = 32 * nb;
#pragma unroll 8
    for (int i = 0; i < 32; ++i) { const int kk = 2 * i + (lane >> 5); scr[kk * 33 + (lane & 31)] = W[(size_t)(k0 + kk) * N + n0 + (lane & 31)]; }
    asm volatile("s_waitcnt lgkmcnt(0)" ::: "memory");
    const int c = lane & 7;
#pragma unroll
    for (int j = 0; j < 4; ++j) { const int n = (lane >> 3) + 8 * j; const float* s = scr + (8 * c) * 33 + n;
        u32x4 o; o.x = cvt_pk_bf16(s[0 * 33], s[1 * 33]); o.y = cvt_pk_bf16(s[2 * 33], s[3 * 33]); o.z = cvt_pk_bf16(s[4 * 33], s[5 * 33]); o.w = cvt_pk_bf16(s[6 * 33], s[7 * 33]);
        *(u32x4*)(WT + (size_t)(n0 + n) * K + k0 + 8 * c) = o; }
    asm volatile("s_waitcnt lgkmcnt(0)" ::: "memory");
}
__device__ __forceinline__ void xpose_job(const float* W, int K, int N, bf16_t* WT, float* scr, int gw, int nw, int lane) {
    const int items = (K / 64) * (N / 32);
    for (int it = gw; it < items; it += nw) xpose_item(W, K, N, WT, scr, it, lane);
}
__device__ __forceinline__ void phase_weights(KP p, char* lds, int wv) {
    asm volatile("" : "+s"(p));
    const int tid = otid(wv), lane = tid & 63, wid = wv, gw = obid() * NWAVES + wid, nw = gridDim.x * NWAVES;
    float* scr = (float*)lds + wid * (64 * 33);
    unsigned char* ws = p->ws;
    for (int j = 0; j < 2; ++j) {
        xpose_job(p->in[3] + (size_t)j * DM * EIN, DM, EIN, (bf16_t*)(ws + WS_WINE) + (size_t)j * EINP * DM, scr, gw, nw, lane);
        xpose_job(p->in[6] + (size_t)j * 384 * 1536, 384, 1536, (bf16_t*)(ws + WS_WUQ) + (size_t)j * 1536 * 384, scr, gw, nw, lane);
        xpose_job(p->in[7] + (size_t)j * 256 * 2048, 256, 2048, (bf16_t*)(ws + WS_WUKV) + (size_t)j * 2048 * 256, scr, gw, nw, lane);
        xpose_job(p->in[13] + (size_t)j * DI * DM, DI, DM, (bf16_t*)(ws + WS_WOUTE) + (size_t)j * DM * DI, scr, gw, nw, lane);
        xpose_job(p->in[14] + (size_t)j * DM * OIN, DM, OIN, (bf16_t*)(ws + WS_WINO) + (size_t)j * OIN * DM, scr, gw, nw, lane);
        xpose_job(p->in[22] + (size_t)j * DI * DM, DI, DM, (bf16_t*)(ws + WS_WOUTO) + (size_t)j * DM * DI, scr, gw, nw, lane);
        for (int it = gw; it < 64 * 8; it += nw) { const int mat = it >> 3, sub = it & 7, dn = mat >> 1, gate = mat & 1;
            const float* src = (gate ? p->in[19] : p->in[17]) + ((size_t)j * 32 + dn) * 16384;
            bf16_t* dst = (bf16_t*)(ws + WS_WG) + (((size_t)j * 32 + dn) * 256 + gate * 128) * 128;
            xpose_item(src, 128, 128, dst, scr, sub, lane); }
        { float* spt = (float*)(ws + WS_SP) + (size_t)j * 2 * DI; const float* lamp = p->in[21] + (size_t)j * 2 * DI;
          for (int i = obid() * NTHR + tid; i < 2 * DI; i += gridDim.x * NTHR) spt[i] = 8.0f * log1pf(__expf(-lamp[i])) * 1.4426950408889634f; }
        { bf16_t* padp = (bf16_t*)(ws + WS_WINE) + (size_t)j * EINP * DM + (size_t)EIN * DM;
          for (int i = obid() * NTHR + tid; i < (EINP - EIN) * DM / 8; i += gridDim.x * NTHR) *(u32x4*)(padp + (size_t)i * 8) = (u32x4){0u, 0u, 0u, 0u}; }
    }
}
__device__ __forceinline__ void phase_norm(KP p, int layer, int g, int wv) {
    asm volatile("" : "+s"(p));
    const int tid = otid(wv), lane = tid & 63, gw = obid() * NWAVES + wv, nw = gridDim.x * NWAVES;
    const float* gn = p->in[2] + (size_t)layer * DM; bf16_t* z = (bf16_t*)(p->ws + A_Z);
    f32x4 gv[4];
#pragma unroll
    for (int j = 0; j < 4; ++j) gv[j] = *(const f32x4*)(gn + lane * 4 + 256 * j);
    const int nq = (R / 4 / nw) * nw;
    for (int lr = nq * 4 + gw; lr < R; lr += nw) {
        const int bl = lr / T, t = lr - bl * T; const float* src = h_src(p, layer, g * GB + bl, t);
        f32x4 v1[4]; float s1 = 0.f;
#pragma unroll
        for (int j = 0; j < 4; ++j) { v1[j] = *(const f32x4*)(src + lane * 4 + 256 * j); s1 += (v1[j].x * v1[j].x + v1[j].y * v1[j].y) + (v1[j].z * v1[j].z + v1[j].w * v1[j].w); }
        const float rstd = rsqrtf(wave_sum(s1) * (1.f / DM) + EPS);
#pragma unroll
        for (int j = 0; j < 4; ++j) { u32x2 o; o.x = cvt_pk_bf16(v1[j].x * rstd * gv[j].x, v1[j].y * rstd * gv[j].y); o.y = cvt_pk_bf16(v1[j].z * rstd * gv[j].z, v1[j].w * rstd * gv[j].w);
            *(u32x2*)(z + (size_t)lr * DM + lane * 4 + 256 * j) = o; }
    }
    for (int q = gw; q < nq; q += nw) {
        f32x4 v[4][4]; float s[4];
#pragma unroll
        for (int k = 0; k < 4; ++k) { const int lr = q * 4 + k, bl = lr / T, t = lr - bl * T; const float* src = h_src(p, layer, g * GB + bl, t);
#pragma unroll
            for (int j = 0; j < 4; ++j) v[k][j] = *(const f32x4*)(src + lane * 4 + 256 * j); }
#pragma unroll
        for (int k = 0; k < 4; ++k) { s[k] = 0.f;
#pragma unroll
            for (int j = 0; j < 4; ++j) s[k] += (v[k][j].x * v[k][j].x + v[k][j].y * v[k][j].y) + (v[k][j].z * v[k][j].z + v[k][j].w * v[k][j].w); }
#pragma unroll
        for (int k = 0; k < 4; ++k) { const float rstd = rsqrtf(wave_sum(s[k]) * (1.f / DM) + EPS); const int lr = q * 4 + k;
#pragma unroll
            for (int j = 0; j < 4; ++j) { u32x2 o; o.x = cvt_pk_bf16(v[k][j].x * rstd * gv[j].x, v[k][j].y * rstd * gv[j].y); o.y = cvt_pk_bf16(v[k][j].z * rstd * gv[j].z, v[k][j].w * rstd * gv[j].w);
                *(u32x2*)(z + (size_t)lr * DM + lane * 4 + 256 * j) = o; } }
    }
}
__device__ __forceinline__ void phase_prep_even(KP p, int j, int g, int wv) {
    asm volatile("" : "+s"(p));
    const int tid = otid(wv), lane = tid & 63, gw = obid() * NWAVES + wv, nw = gridDim.x * NWAVES;
    bf16_t* zp = (bf16_t*)(p->ws + A_ZP); bf16_t* cqn = (bf16_t*)(p->ws + A_CQN); bf16_t* ckvn = (bf16_t*)(p->ws + A_CKVN);
    const float* gq = p->in[4] + (size_t)j * 384; const float* gkv = p->in[5] + (size_t)j * 256;
    const float* sgq = p->in[10] + (size_t)j * 128; const float* sgk = p->in[11] + (size_t)j * 128;
    const float inv = exp2f(-(float)(2 * lane) * (13.287712379549449f / 128.f));
    const float gq1 = sgq[lane], gq2 = sgq[lane + 64], gk1 = sgk[lane], gk2 = sgk[lane + 64];
    for (int lr0 = gw * 2; lr0 < R; lr0 += nw * 2) {
        u32x4 vq[2], vkv[2]; float x1[2][10], x2[2][10];
#pragma unroll
        for (int k = 0; k < 2; ++k) { const bf16_t* zr = zp + (size_t)(lr0 + k) * EINP;
            vq[k] = (u32x4){0u, 0u, 0u, 0u}; vkv[k] = (u32x4){0u, 0u, 0u, 0u};
            if (lane < 48) vq[k] = *(const u32x4*)(zr + C_CQ + lane * 8);
            if (lane < 32) vkv[k] = *(const u32x4*)(zr + C_CKV + lane * 8);
#pragma unroll
            for (int hh = 0; hh < 10; ++hh) { const bf16_t* hp = zr + (hh < 8 ? C_QS + hh * 128 : C_KS + (hh - 8) * 128); x1[k][hh] = bf2f(hp[lane]); x2[k][hh] = bf2f(hp[lane + 64]); } }
#pragma unroll
        for (int k = 0; k < 2; ++k) { const int lr = lr0 + k, t = lr % T; bf16_t* zr = zp + (size_t)lr * EINP;
            { float ss = 0.f;
#pragma unroll
              for (int e = 0; e < 4; ++e) { const float a = bflo(vq[k][e]), b = bfhi(vq[k][e]); ss += a * a + b * b; }
              const float rstd = rsqrtf(wave_sum(ss) * (1.f / 384.f) + EPS);
              if (lane < 48) { u32x4 o;
#pragma unroll
                  for (int e = 0; e < 4; ++e) o[e] = cvt_pk_bf16(bflo(vq[k][e]) * rstd * gq[lane * 8 + 2 * e], bfhi(vq[k][e]) * rstd * gq[lane * 8 + 2 * e + 1]);
                  *(u32x4*)(cqn + (size_t)lr * 384 + lane * 8) = o; } }
            { float ss = 0.f;
#pragma unroll
              for (int e = 0; e < 4; ++e) { const float a = bflo(vkv[k][e]), b = bfhi(vkv[k][e]); ss += a * a + b * b; }
              const float rstd = rsqrtf(wave_sum(ss) * (1.f / 256.f) + EPS);
              if (lane < 32) { u32x4 o;
#pragma unroll
                  for (int e = 0; e < 4; ++e) o[e] = cvt_pk_bf16(bflo(vkv[k][e]) * rstd * gkv[lane * 8 + 2 * e], bfhi(vkv[k][e]) * rstd * gkv[lane * 8 + 2 * e + 1]);
                  *(u32x4*)(ckvn + (size_t)lr * 256 + lane * 8) = o; } }
            float sn, cs; sincosf((float)t * inv, &sn, &cs);
#pragma unroll
            for (int hh = 0; hh < 10; ++hh) {
                const float rstd = rsqrtf(wave_sum(x1[k][hh] * x1[k][hh] + x2[k][hh] * x2[k][hh]) * (1.f / 128.f) + EPS);
                const float y1 = x1[k][hh] * rstd * (hh < 8 ? gq1 : gk1), y2 = x2[k][hh] * rstd * (hh < 8 ? gq2 : gk2);
                x1[k][hh] = y1 * cs - y2 * sn; x2[k][hh] = y1 * sn + y2 * cs;
            }
#pragma unroll
            for (int hh = 0; hh < 10; ++hh) { bf16_t* hp = zr + (hh < 8 ? C_QS + hh * 128 : C_KS + (hh - 8) * 128); hp[lane] = f2bf(x1[k][hh]); hp[lane + 64] = f2bf(x2[k][hh]); } }
    }
}
__device__ __forceinline__ void phase_post_mla(KP p, int j, int g, int wv) {
    asm volatile("" : "+s"(p));
    const int tid = otid(wv), lane = tid & 63, gw = obid() * NWAVES + wv, nw = gridDim.x * NWAVES;
    const bf16_t* zp = (const bf16_t*)(p->ws + A_ZP); bf16_t* q = (bf16_t*)(p->ws + A_Q); bf16_t* kb = (bf16_t*)(p->ws + A_K);
    const float* gqn = p->in[8] + (size_t)j * 192; const float* gkn = p->in[9] + (size_t)j * 192;
    const float inv = exp2f(-(float)(2 * (lane & 31)) * (13.287712379549449f / 64.f));
    const float gq0 = gqn[2 * lane], gq1 = gqn[2 * lane + 1], gqr = gqn[128 + lane], gk0 = gkn[2 * lane], gk1 = gkn[2 * lane + 1], gkr = gkn[128 + lane];
    static_assert(R % 2 == 0, "two rows per wave step");
    for (int lr0 = gw * 2; lr0 < R; lr0 += nw * 2) {
        unsigned kn[2][8]; float pe[2], sn[2], cs[2];
#pragma unroll
        for (int k = 0; k < 2; ++k) { const int lr = lr0 + k; const bf16_t* krow = kb + (size_t)lr * 1536;
            pe[k] = bf2f(zp[(size_t)lr * EINP + C_KPE + lane]);
#pragma unroll
            for (int h = 0; h < 8; ++h) kn[k][h] = *(const unsigned*)(krow + h * 192 + 2 * lane); }
#pragma unroll
        for (int k = 0; k < 2; ++k) { const int lr = lr0 + k, t = lr % T; sincosf((float)t * inv, &sn[k], &cs[k]);
            bf16_t* krow = kb + (size_t)lr * 1536;
            const float pess = wave_sum(pe[k] * pe[k]);
#pragma unroll
            for (int h = 0; h < 8; ++h) {
                const float n0 = bflo(kn[k][h]), n1 = bfhi(kn[k][h]);
                const float rstd = rsqrtf((wave_sum(n0 * n0 + n1 * n1) + pess) * (1.f / 192.f) + EPS);
                kn[k][h] = cvt_pk_bf16(n0 * rstd * gk0, n1 * rstd * gk1);
                const float y = pe[k] * rstd * gkr; auto rr = __builtin_amdgcn_permlane32_swap(__float_as_uint(y), __float_as_uint(y), false, false);
                const float x1 = __uint_as_float(rr[0]), x2 = __uint_as_float(rr[1]);
                krow[h * 192 + 128 + lane] = f2bf(lane < 32 ? x1 * cs[k] - x2 * sn[k] : x1 * sn[k] + x2 * cs[k]);
            }
#pragma unroll
            for (int h = 0; h < 8; ++h) *(unsigned*)(krow + h * 192 + 2 * lane) = kn[k][h]; }
    }
}
__device__ __forceinline__ void phase_conv(KP p, int j, int wv) {
    asm volatile("" : "+s"(p));
    const bf16_t* u = (const bf16_t*)(p->ws + A_ZP); bf16_t* xc = (bf16_t*)(p->ws + A_XC);
    const float* cw = p->in[15] + (size_t)j * 4 * DI; const float* cb = p->in[16] + (size_t)j * DI;
    static_assert(T % 16 == 0 && R % 16 == 0, "conv strips");
    const int nthr = gridDim.x * NTHR, nst = ((R / 16) * (DI / 8) / nthr) * nthr;
    for (int task = obid() * NTHR + otid(wv); task < (R - (nst >> 8) * 16) * (DI / 8); task += nthr) {
        const int lr = (nst >> 8) * 16 + (task >> 8), c0 = (task & 255) * 8, t = lr % T;
        float acc[8];
#pragma unroll
        for (int e = 0; e < 8; ++e) acc[e] = cb[c0 + e];
#pragma unroll
        for (int tap = 0; tap < 4; ++tap) { const int tt = t + tap - 2;
            if (tt >= 0 && tt < T) { const u32x4 v = *(const u32x4*)(u + (size_t)(lr + tap - 2) * OIN + c0); const float* w = cw + tap * DI + c0;
#pragma unroll
                for (int e = 0; e < 4; ++e) { acc[2 * e] += bflo(v[e]) * w[2 * e]; acc[2 * e + 1] += bfhi(v[e]) * w[2 * e + 1]; } } }
        u32x4 o;
#pragma unroll
        for (int e = 0; e < 4; ++e) o[e] = cvt_pk_bf16(acc[2 * e], acc[2 * e + 1]);
        *(u32x4*)(xc + (size_t)lr * DI + c0) = o;
    }
    for (int task = obid() * NTHR + otid(wv); task < nst; task += nthr) {
        const int c0 = (task & 255) * 8, lr0 = (task >> 8) * 16, t0 = lr0 % T;
        float w[4][8], bias[8];
#pragma unroll
        for (int e = 0; e < 8; ++e) { bias[e] = cb[c0 + e];
#pragma unroll
            for (int tap = 0; tap < 4; ++tap) w[tap][e] = cw[tap * DI + c0 + e]; }
        u32x4 rows[19];
#pragma unroll
        for (int k = 0; k < 19; ++k) { const int tt = t0 + k - 2;
            rows[k] = (tt >= 0 && tt < T) ? *(const u32x4*)(u + (size_t)(lr0 + k - 2) * OIN + c0) : (u32x4){0u, 0u, 0u, 0u}; }
#pragma unroll
        for (int r = 0; r < 16; ++r) { float acc[8];
#pragma unroll
            for (int e = 0; e < 8; ++e) acc[e] = bias[e];
#pragma unroll
            for (int tap = 0; tap < 4; ++tap) { const u32x4 v = rows[r + tap];
#pragma unroll
                for (int e = 0; e < 4; ++e) { acc[2 * e] += bflo(v[e]) * w[tap][2 * e]; acc[2 * e + 1] += bfhi(v[e]) * w[tap][2 * e + 1]; } }
            u32x4 o;
#pragma unroll
            for (int e = 0; e < 4; ++e) o[e] = cvt_pk_bf16(acc[2 * e], acc[2 * e + 1]);
            *(u32x4*)(xc + (size_t)(lr0 + r) * DI + c0) = o; }
    }
}
__device__ __forceinline__ int chunk_start(int k) { return (k * T) / NCH; }
__device__ __forceinline__ void phase_scan_a(KP p, int d, int wv) {
    asm volatile("" : "+s"(p));
    const bf16_t* LA = (const bf16_t*)(p->ws + A_LA); const bf16_t* BB = (const bf16_t*)(p->ws + A_BB);
    float* CP = (float*)(p->ws + WS_CARP); float* CH = (float*)(p->ws + WS_CARH);
    for (int task = obid() * NTHR + otid(wv); task < GB * NCH * (DI / 4); task += gridDim.x * NTHR) {
        const int cp = task & 511, ck = (task >> 9) & (NCH - 1), bl = task / (512 * NCH);
        const int t0 = chunk_start(ck), t1 = chunk_start(ck + 1), n = t1 - t0;
        const size_t base = (size_t)bl * T * DI + 4 * cp;
        float s[4] = {0.f, 0.f, 0.f, 0.f}, h[4] = {0.f, 0.f, 0.f, 0.f};
        for (int i0 = 0; i0 < n; i0 += 16) { const int nb = n - i0;
            u32x2 la[16], bb[16];
#pragma unroll
            for (int k = 0; k < 16; ++k) if (k < nb) { const int t = d == 0 ? t0 + i0 + k : t1 - 1 - i0 - k;
                la[k] = *(const u32x2*)(LA + base + (size_t)t * DI); bb[k] = *(const u32x2*)(BB + base + (size_t)t * DI); }
#pragma unroll
            for (int k = 0; k < 16; ++k) if (k < nb) {
                const float l0 = h2lo(la[k].x), l1 = h2hi(la[k].x), l2 = h2lo(la[k].y), l3 = h2hi(la[k].y);
                h[0] = __builtin_amdgcn_exp2f(l0) * h[0] + bflo(bb[k].x); h[1] = __builtin_amdgcn_exp2f(l1) * h[1] + bfhi(bb[k].x);
                h[2] = __builtin_amdgcn_exp2f(l2) * h[2] + bflo(bb[k].y); h[3] = __builtin_amdgcn_exp2f(l3) * h[3] + bfhi(bb[k].y);
                s[0] += l0; s[1] += l1; s[2] += l2; s[3] += l3; } }
        const size_t ci = ((size_t)bl * NCH + ck) * DI + 4 * cp;
        *(f32x4*)(CP + ci) = (f32x4){__builtin_amdgcn_exp2f(s[0]), __builtin_amdgcn_exp2f(s[1]), __builtin_amdgcn_exp2f(s[2]), __builtin_amdgcn_exp2f(s[3])};
        *(f32x4*)(CH + ci) = (f32x4){h[0], h[1], h[2], h[3]};
    }
}
__device__ __forceinline__ void phase_scan_b(KP p, int d, int wv) {
    asm volatile("" : "+s"(p));
    const bf16_t* LA = (const bf16_t*)(p->ws + A_LA); const bf16_t* BB = (const bf16_t*)(p->ws + A_BB);
    bf16_t* zp = (bf16_t*)(p->ws + A_ZP);
    const float* CP = (const float*)(p->ws + WS_CARP); const float* CH = (const float*)(p->ws + WS_CARH);
    for (int task = obid() * NTHR + otid(wv); task < GB * NCH * (DI / 4); task += gridDim.x * NTHR) {
        const int cp = task & 511, ck = (task >> 9) & (NCH - 1), bl = task / (512 * NCH);
        const int t0 = chunk_start(ck), t1 = chunk_start(ck + 1), n = t1 - t0;
        f32x4 h = {0.f, 0.f, 0.f, 0.f};
        { const int nprev = d == 0 ? ck : NCH - 1 - ck;
          for (int i = 0; i < nprev; ++i) { const int c = d == 0 ? i : NCH - 1 - i; const size_t ci = ((size_t)bl * NCH + c) * DI + 4 * cp;
              const f32x4 P = *(const f32x4*)(CP + ci), H = *(const f32x4*)(CH + ci); h = P * h + H; } }
        const size_t base = (size_t)bl * T * DI + 4 * cp; const size_t ybase = (size_t)bl * T * OIN + 4 * cp;
        for (int i0 = 0; i0 < n; i0 += 16) { const int nb = n - i0;
            u32x2 la[16], bb[16], yv[16], gv[16];
#pragma unroll
            for (int k = 0; k < 16; ++k) if (k < nb) { const int t = d == 0 ? t0 + i0 + k : t1 - 1 - i0 - k;
                la[k] = *(const u32x2*)(LA + base + (size_t)t * DI); bb[k] = *(const u32x2*)(BB + base + (size_t)t * DI);
                if (d != 0) { yv[k] = *(const u32x2*)(zp + ybase + (size_t)t * OIN); gv[k] = *(const u32x2*)(zp + ybase + (size_t)t * OIN + DI); } }
#pragma unroll
            for (int k = 0; k < 16; ++k) if (k < nb) { const int t = d == 0 ? t0 + i0 + k : t1 - 1 - i0 - k;
                h[0] = __builtin_amdgcn_exp2f(h2lo(la[k].x)) * h[0] + bflo(bb[k].x); h[1] = __builtin_amdgcn_exp2f(h2hi(la[k].x)) * h[1] + bfhi(bb[k].x);
                h[2] = __builtin_amdgcn_exp2f(h2lo(la[k].y)) * h[2] + bflo(bb[k].y); h[3] = __builtin_amdgcn_exp2f(h2hi(la[k].y)) * h[3] + bfhi(bb[k].y);
                u32x2 o;
                if (d == 0) { o.x = cvt_pk_bf16(h[0], h[1]); o.y = cvt_pk_bf16(h[2], h[3]); }
                else { o.x = cvt_pk_bf16((bflo(yv[k].x) + h[0]) * siluf_(bflo(gv[k].x)), (bfhi(yv[k].x) + h[1]) * siluf_(bfhi(gv[k].x)));
                       o.y = cvt_pk_bf16((bflo(yv[k].y) + h[2]) * siluf_(bflo(gv[k].y)), (bfhi(yv[k].y) + h[3]) * siluf_(bfhi(gv[k].y))); }
                *(u32x2*)(zp + ybase + (size_t)t * OIN) = o; } }
    }
}

__device__ __forceinline__ void phase_attn(KP p, int j, char* lds, int wv) {
    asm volatile("" : "+s"(p));
    const int G = gridDim.x, bx = obid(), vcu = (G % 8 == 0) ? (bx % 8) * (G / 8) + bx / 8 : bx;
    bf16_t* zp = (bf16_t*)(p->ws + A_ZP); const bf16_t* q = (const bf16_t*)(p->ws + A_Q); const bf16_t* kb = (const bf16_t*)(p->ws + A_K); const bf16_t* vb = (const bf16_t*)(p->ws + A_V);
    constexpr int NFULL = GB * 8 * 16, NTAIL = GB * 8, NSWA = GB * 8 * 17;
#ifndef ATT_REP
#define ATT_REP 1
#endif
    const int nfl = (NFULL - vcu + G - 1) / G;
    const bool split = G > NTAIL; const int nsw = split ? G - NTAIL : G, sb = split ? vcu - NTAIL : vcu;
    const int ntl = split ? (vcu < NTAIL ? 1 : 0) : (NTAIL - vcu + G - 1) / G;
    const int nsv = sb >= 0 ? (NSWA - sb + nsw - 1) / nsw : 0;
    for (int rp = 0; rp < ATT_REP; ++rp)
    for (int it = 0; it < nfl + ntl + nsv; ++it) {
        const bool dostore = rp == ATT_REP - 1;
        if (it < nfl + ntl) {
            int bh, qb; if (it < nfl) { const int u = vcu + it * G; bh = u >> 4; qb = u & 15; } else { bh = vcu + (it - nfl) * G; qb = 16; }
            const int bl = bh >> 3, h = bh & 7; const size_t r0 = (size_t)bl * T;
            att::attn_unit<192, 1536, 1536, 1024, false>(q + r0 * 1536 + h * 192, kb + r0 * 1536 + h * 192, vb + r0 * 1024 + h * 128,
                                                          zp + r0 * EINP + C_GATE + h * 128, qb * 256, 66, 0, -1e30f, 0.f, lds, (LAS unsigned char*)lds, wv, dostore, p->in[8] + (size_t)j * 192);
        } else {
            const int v = sb + (it - nfl - ntl) * nsw, bh = v / 17, qb = v - bh * 17, bl = bh >> 3, h = bh & 7, kvh = h >> 2; const size_t r0 = (size_t)bl * T;
            const int i0 = qb * 256, t64 = i0 / 64, tfirst = t64 >= 2 ? t64 - 2 : 0, tlast = t64 + 6 < 65 ? t64 + 6 : 65;
            int n = tlast - tfirst + (tfirst > 0 ? 1 : 0); n = (n + 1) & ~1;
            const float sink = p->in[12][j * 8 + h];
            att::attn_unit<128, EINP, EINP, EINP, true>(zp + r0 * EINP + C_QS + h * 128, zp + r0 * EINP + C_KS + kvh * 128, zp + r0 * EINP + C_VS + kvh * 128,
                                                         zp + r0 * EINP + C_GATE + 1024 + h * 128, i0, n, tfirst, sink * 11.313708498984761f, 1.f, lds, (LAS unsigned char*)lds, wv, dostore, nullptr);
        }
    }
}

#define XB_TMO      128
#define XB_XCNT(j)  (256  + 64 * (j))
#define XB_XSUB(j)  (1280 + 64 * (j))
#define XB_XGEN(j)  (2304 + 64 * (j))
#define XB_TOP      3328
#define XB_TOPGEN   3392
#define XCD_BAR_WORDS 3456
#define XB_SPIN_CAP (1u << 20)
__device__ __forceinline__ unsigned xb_ld(unsigned* p)              { return __hip_atomic_load(p, __ATOMIC_RELAXED, __HIP_MEMORY_SCOPE_AGENT); }
__device__ __forceinline__ unsigned xb_add(unsigned* p, unsigned v) { return __hip_atomic_fetch_add(p, v, __ATOMIC_RELAXED, __HIP_MEMORY_SCOPE_AGENT); }
__device__ __forceinline__ unsigned xb_xcc_id() { return (unsigned)__builtin_amdgcn_s_getreg((3 << 11) | 20) & 0xFu; }
#define XB_SPIN(cond, bar) do { unsigned _sp = 0; while (cond) { __builtin_amdgcn_s_sleep(1); \
    if ((++_sp & 255u) == 0u) { if (xb_ld(&(bar)[XB_TMO])) break; if (_sp > XB_SPIN_CAP) { atomicAdd(&(bar)[XB_TMO], 1u); break; } } } } while (0)
__device__ __forceinline__ void xcd_barrier_complete(unsigned* bar, unsigned x, unsigned G, unsigned& nloc, unsigned& nx) {
    unsigned sum, cnt, mine, sp = 0u;
    for (;;) {
        sum = 0u; cnt = 0u; mine = 0u;
#pragma unroll
        for (unsigned j = 0; j < 16; ++j) { const unsigned c = xb_ld(&bar[XB_XCNT(j)]); sum += c; cnt += (c > 0u) ? 1u : 0u; mine = (j == x) ? c : mine; }
        if (sum == G) break;
        __builtin_amdgcn_s_sleep(1);
        if ((++sp & 255u) == 0u) { if (xb_ld(&bar[XB_TMO])) break; if (sp > XB_SPIN_CAP) { atomicAdd(&bar[XB_TMO], 1u); break; } }
    }
    nloc = mine > 0u ? mine : 1u; nx = cnt > 0u ? cnt : 1u;
}
__device__ __forceinline__ void grid_bar(unsigned* bar, unsigned x, volatile LAS unsigned* st, unsigned G, int wv, int lane) {
    asm volatile("s_waitcnt vmcnt(0)" ::: "memory");
    __syncthreads();
    if (wv == 0 && lane == 0) {
        __builtin_amdgcn_s_waitcnt(0);
        unsigned nloc = st[0], nx = st[1];
        if (nloc == 0u) { xcd_barrier_complete(bar, x, G, nloc, nx); st[0] = nloc; st[1] = nx; }
        const unsigned old = xb_add(&bar[XB_XSUB(x)], 1u);
        const unsigned gen = old / nloc;
        if (old + 1u == (gen + 1u) * nloc) {
            __builtin_amdgcn_fence(__ATOMIC_RELEASE, "agent");
            asm volatile("s_waitcnt vmcnt(0)" ::: "memory");
            const unsigned og = xb_add(&bar[XB_TOP], 1u);
            const unsigned tg = og / nx;
            if (og + 1u == (tg + 1u) * nx) xb_add(&bar[XB_TOPGEN], 1u);
            else XB_SPIN(xb_ld(&bar[XB_TOPGEN]) == tg, bar);
            __builtin_amdgcn_fence(__ATOMIC_ACQUIRE, "agent");
            xb_add(&bar[XB_XGEN(x)], 1u);
            asm volatile("s_waitcnt vmcnt(0)" ::: "memory");
        } else {
            XB_SPIN(xb_ld(&bar[XB_XGEN(x)]) == gen, bar);
            __builtin_amdgcn_fence(__ATOMIC_ACQUIRE, "agent");
            asm volatile("s_waitcnt vmcnt(0)" ::: "memory");
        }
    }
    __syncthreads();
}

__global__ void __launch_bounds__(NTHR, 2) hybrid_fwd(Params p_unused) {
    extern __shared__ __attribute__((aligned(16))) unsigned char lds[];
    const int wv = __builtin_amdgcn_readfirstlane((int)(threadIdx.x >> 6));
    const unsigned G = gridDim.x;
    LAS unsigned char* ldsl = (LAS unsigned char*)lds;
    KP kp = (KP)__builtin_amdgcn_kernarg_segment_ptr();
    unsigned* barw = (unsigned*)(kp->ws + WS_BAR);
    volatile LAS unsigned* bst = (volatile LAS unsigned*)(ldsl + 131072 + 64);
    const unsigned xcc = xb_xcc_id();
    if (threadIdx.x == 0) { bst[0] = 0u; bst[1] = 0u; (void)xb_add(&barw[XB_XCNT(xcc)], 1u); }
    __syncthreads();
#define GBAR() do { grid_bar(barw, xcc, bst, G, wv, olane()); } while (0)
    phase_weights(kp, (char*)lds, wv);
    phase_norm(kp, 0, 0, wv);
    if (gridDim.y == 0x7fffffffu) cg::this_grid().sync();
    GBAR();
    for (int g = 0; g < NG; ++g) {
        for (int layer = 0; layer < 4; ++layer) {
            const int j = layer >> 1, bx = obid();
            if (layer != 0) { phase_norm(kp, layer, g, wv); GBAR(); }
            KP p = kp; asm volatile("" : "+s"(p));
            unsigned char* ws = p->ws;
            if ((layer & 1) == 0) {
                { pg8::Gemm gm{(const bf16_t*)(ws + A_Z), (const bf16_t*)(ws + WS_WINE) + (size_t)j * EINP * DM}; pg8::StaticOrder S; S.init(RP, EINP, G, bx);
                  pg8::EpiStore E{(bf16_t*)(ws + A_ZP), EINP};
                  pg8::gemm_phase<DM, DM, DM, 0, pg8::EpiStore, pg8::StaticOrder, false, true>(ldsl, gm, S, E, wv); }
                GBAR();
                phase_prep_even(kp, j, g, wv);
                GBAR();
                { pg8::Gemm gm{(const bf16_t*)(ws + A_CQN), (const bf16_t*)(ws + WS_WUQ) + (size_t)j * 1536 * 384}; pg8::StaticOrder S; S.init(RP, 1536, G, bx);
                  pg8::EpiStore E{(bf16_t*)(ws + A_Q), 1536};
                  pg8::gemm_phase<384, 384, 384, 0, pg8::EpiStore, pg8::StaticOrder, true, true>(ldsl, gm, S, E, wv); }
                { pg8::Gemm gm{(const bf16_t*)(ws + A_CKVN), (const bf16_t*)(ws + WS_WUKV) + (size_t)j * 2048 * 256}; pg8::StaticOrder S; S.init(RP, 2048, G, (int)G - 1 - bx);
                  pg8::EpiKV E{(bf16_t*)(ws + A_K), (bf16_t*)(ws + A_V)};
                  pg8::gemm_phase<256, 256, 256, 0, pg8::EpiKV, pg8::StaticOrder, true, true>(ldsl, gm, S, E, wv); }
                GBAR();
                phase_post_mla(kp, j, g, wv);
                GBAR();
                phase_attn(kp, j, (char*)lds, wv);
                GBAR();
                { pg8::Gemm gm{(const bf16_t*)(ws + A_ZP) + C_GATE, (const bf16_t*)(ws + WS_WOUTE) + (size_t)j * DM * DI}; pg8::TailOrder S; S.init(RP, DM, G, bx);
                  pg8::EpiRes E{p->in[0], p->in[1], p->out, (float*)(ws + WS_HMETA), layer, g};
                  pg8::gemm_phase<EINP, DI, DI, 0, pg8::EpiRes, pg8::TailOrder, true, true, RP / 256 - 1>(ldsl, gm, S, E, wv); }
                GBAR();
            } else {
                { pg8::Gemm gm{(const bf16_t*)(ws + A_Z), (const bf16_t*)(ws + WS_WINO) + (size_t)j * OIN * DM}; pg8::StaticOrder S; S.init(RP, OIN, G, bx);
                  pg8::EpiStore E{(bf16_t*)(ws + A_ZP), OIN};
                  pg8::gemm_phase<DM, DM, DM, 0, pg8::EpiStore, pg8::StaticOrder, false, true>(ldsl, gm, S, E, wv); }
                GBAR();
                phase_conv(kp, j, wv);
                GBAR();
                for (int d = 0; d < 2; ++d) {
                    { pg8::Gemm gm{(const bf16_t*)(ws + A_XC), (const bf16_t*)(ws + WS_WG) + (size_t)(j * 2 + d) * 16 * 256 * 128}; pg8::TailOrder S; S.init(RP, 16 * 256, G, bx);
                      pg8::EpiGate E{(const bf16_t*)(ws + A_XC), (bf16_t*)(ws + A_LA), (bf16_t*)(ws + A_BB),
                                     p->in[18] + (size_t)(j * 2 + d) * DI, p->in[20] + (size_t)(j * 2 + d) * DI, (const float*)(ws + WS_SP) + (size_t)(j * 2 + d) * DI};
                      pg8::gemm_phase<DI, 128, 128, 128, pg8::EpiGate, pg8::TailOrder, true, true>(ldsl, gm, S, E, wv); }
                    GBAR();
                    phase_scan_a(kp, d, wv);
                    GBAR();
                    phase_scan_b(kp, d, wv);
                    GBAR();
                }
                { pg8::Gemm gm{(const bf16_t*)(ws + A_ZP), (const bf16_t*)(ws + WS_WOUTO) + (size_t)j * DM * DI}; pg8::TailOrder S; S.init(RP, DM, G, bx);
                  pg8::EpiRes E{p->in[0], p->in[1], p->out, (float*)(ws + WS_HMETA), layer, g};
                  pg8::gemm_phase<OIN, DI, DI, 0, pg8::EpiRes, pg8::TailOrder, true, true, RP / 256 - 1>(ldsl, gm, S, E, wv); }
                if (layer == 3 && g + 1 < NG) phase_norm(kp, 0, g + 1, wv);
                GBAR();
            }
        }
    }
#undef GBAR
}

extern "C" void kernel_launch(void* const* d_in, const int* in_sizes, int n_in, void* d_out, int out_size, void* d_ws, size_t ws_size, hipStream_t stream) {
    static int grid = 0;
    if (grid == 0) {
        if (n_in != 23 || out_size != NBATCH * SEQ * DM || ws_size < WS_NEED) { fprintf(stderr, "kernel_launch: unexpected shapes (n_in %d out %d ws %zu need %zu)\n", n_in, out_size, ws_size, (size_t)WS_NEED); grid = -1; return; }
        int dev = 0, cus = 0, per_cu = 0;
        hipGetDevice(&dev); hipDeviceGetAttribute(&cus, hipDeviceAttributeMultiprocessorCount, dev);
        if (hipFuncSetAttribute((const void*)hybrid_fwd, hipFuncAttributeMaxDynamicSharedMemorySize, LDS_BYTES) != hipSuccess) { fprintf(stderr, "kernel_launch: hipFuncSetAttribute failed\n"); grid = -1; return; }
        if (hipOccupancyMaxActiveBlocksPerMultiprocessor(&per_cu, (const void*)hybrid_fwd, NTHR, LDS_BYTES) != hipSuccess || per_cu < 1) { fprintf(stderr, "kernel_launch: occupancy query failed (%d)\n", per_cu); per_cu = 1; (void)hipGetLastError(); }
        grid = cus * per_cu;
    }
    if (grid < 0) return;
    Params p{};
    for (int i = 0; i < 23; ++i) p.in[i] = (const float*)d_in[i];
    p.out = (float*)d_out; p.ws = (unsigned char*)d_ws;
    (void)hipMemsetAsync((char*)d_ws + WS_BAR, 0, 16384, stream);
    void* args[] = {&p};
    hipError_t e = hipLaunchCooperativeKernel((const void*)hybrid_fwd, dim3(grid), dim3(NTHR), args, LDS_BYTES, stream);
    if (e != hipSuccess) fprintf(stderr, "cooperative launch failed: %s (grid %d)\n", hipGetErrorString(e), grid);
}
```

```cpp
#include <hip/hip_runtime.h>
#include <hip/hip_cooperative_groups.h>
#include <cstdio>
#include <cstdint>
namespace cg = cooperative_groups;

constexpr int NBATCH = 8, SEQ = 4096, NMETA = 16, T = SEQ + NMETA, DM = 1024, DI = 2048;
constexpr int GB = 4, NG = NBATCH / GB, R = GB * T, RP = ((R + 255) / 256) * 256;
constexpr int EIN = 4288, EINP = 4352, OIN = 4096;
constexpr int C_CQ = 0, C_CKV = 384, C_KPE = 640, C_QS = 704, C_KS = 1728, C_VS = 1984, C_GATE = 2240;
constexpr float EPS = 1e-6f;
constexpr int NCH = 64;
constexpr int NWAVES = 8, NTHR = 512;
constexpr int LDS_BYTES = 139264;

constexpr size_t al256(size_t x) { return (x + 255) / 256 * 256; }
constexpr size_t WS_WINE = 0;
constexpr size_t WS_WUQ = WS_WINE + (size_t)2 * EINP * DM * 2;
constexpr size_t WS_WUKV = WS_WUQ + (size_t)2 * 1536 * 384 * 2;
constexpr size_t WS_WOUTE = WS_WUKV + (size_t)2 * 2048 * 256 * 2;
constexpr size_t WS_WINO = WS_WOUTE + (size_t)2 * DM * DI * 2;
constexpr size_t WS_WOUTO = WS_WINO + (size_t)2 * OIN * DM * 2;
constexpr size_t WS_WG = WS_WOUTO + (size_t)2 * DM * DI * 2;
constexpr size_t WS_HMETA = WS_WG + (size_t)2 * 2 * 16 * 256 * 128 * 2;
constexpr size_t WS_CARP = WS_HMETA + (size_t)NBATCH * NMETA * DM * 4;
constexpr size_t WS_CARH = WS_CARP + (size_t)GB * NCH * DI * 4;
constexpr size_t WS_SP = WS_CARH + (size_t)GB * NCH * DI * 4;
constexpr size_t WS_BAR = WS_SP + (size_t)4 * DI * 4;
constexpr size_t WS_ACT = (size_t)64 << 20;
static_assert(WS_BAR + 16384 <= WS_ACT, "weights region");
constexpr size_t A_Z = WS_ACT;
constexpr size_t A_ZP = A_Z + (size_t)RP * DM * 2;
constexpr size_t A_CQN = A_ZP + (size_t)RP * EINP * 2;
constexpr size_t A_CKVN = A_CQN + (size_t)RP * 384 * 2;
constexpr size_t A_Q = A_CKVN + (size_t)RP * 256 * 2;
constexpr size_t A_K = A_Q + (size_t)RP * 1536 * 2;
constexpr size_t A_V = A_K + (size_t)RP * 1536 * 2;
constexpr size_t A_END_E = A_V + (size_t)RP * 1024 * 2;
constexpr size_t A_XC = A_ZP + (size_t)RP * OIN * 2;
constexpr size_t A_LA = A_XC + (size_t)RP * DI * 2;
constexpr size_t A_BB = A_LA + (size_t)RP * DI * 2;
constexpr size_t A_END_O = A_BB + (size_t)RP * DI * 2;
constexpr size_t WS_NEED = A_END_E > A_END_O ? A_END_E : A_END_O;
static_assert(WS_NEED <= ((size_t)512 << 20), "workspace budget");

struct Params { const float* in[23]; float* out; unsigned char* ws; };
typedef const Params __attribute__((address_space(4)))* KP;

typedef unsigned short bf16_t;
typedef short bf16x8 __attribute__((ext_vector_type(8)));
typedef short s16x4 __attribute__((ext_vector_type(4)));
typedef float f32x4 __attribute__((ext_vector_type(4)));
typedef float f32x16 __attribute__((ext_vector_type(16)));
typedef unsigned u32x4 __attribute__((ext_vector_type(4)));
typedef unsigned u32x2 __attribute__((ext_vector_type(2)));
#define LAS __attribute__((address_space(3)))

__device__ __forceinline__ unsigned cvt_pk_bf16(float lo, float hi) { unsigned r; asm volatile("v_cvt_pk_bf16_f32 %0, %1, %2" : "=v"(r) : "v"(lo), "v"(hi)); return r; }
__device__ __forceinline__ float bf2f(unsigned short v) { return __uint_as_float((unsigned)v << 16); }
__device__ __forceinline__ float bflo(unsigned v) { return __uint_as_float(v << 16); }
__device__ __forceinline__ float bfhi(unsigned v) { return __uint_as_float(v & 0xffff0000u); }
__device__ __forceinline__ unsigned short f2bf(float f) { return (unsigned short)(cvt_pk_bf16(f, 0.f) & 0xffffu); }
typedef _Float16 h2_t __attribute__((ext_vector_type(2)));
__device__ __forceinline__ unsigned pk_h2(float a, float b) { h2_t v = {(_Float16)a, (_Float16)b}; return __builtin_bit_cast(unsigned, v); }
__device__ __forceinline__ float h2lo(unsigned u) { h2_t v = __builtin_bit_cast(h2_t, u); return (float)v[0]; }
__device__ __forceinline__ float h2hi(unsigned u) { h2_t v = __builtin_bit_cast(h2_t, u); return (float)v[1]; }
template <int CTRL> __device__ __forceinline__ float dppx(float v) { return __int_as_float(__builtin_amdgcn_update_dpp(0, __float_as_int(v), CTRL, 0xf, 0xf, false)); }
__device__ __forceinline__ float wave_sum(float v) {
    v += dppx<0xB1>(v); v += dppx<0x4E>(v); v += dppx<0x141>(v); v += dppx<0x140>(v);
    v += __int_as_float(__builtin_amdgcn_ds_swizzle(__float_as_int(v), 0x401F));
    auto rr = __builtin_amdgcn_permlane32_swap(__float_as_uint(v), __float_as_uint(v), false, false);
    return __uint_as_float(rr[0]) + __uint_as_float(rr[1]);
}
__device__ __forceinline__ int olane() { int l; asm volatile("v_mbcnt_lo_u32_b32 %0, -1, 0\n\tv_mbcnt_hi_u32_b32 %0, -1, %0" : "=v"(l)); return l; }
__device__ __forceinline__ int otid(int wv) { return wv * 64 + olane(); }
__device__ __forceinline__ int obid() { int b = blockIdx.x; asm volatile("" : "+s"(b)); return b; }
__device__ __forceinline__ float sigmoidf_(float x) { return __builtin_amdgcn_rcpf(1.f + __expf(-x)); }
__device__ __forceinline__ float siluf_(float x) { return x * __builtin_amdgcn_rcpf(1.f + __expf(-x)); }

__device__ __forceinline__ const float* h_src(KP p, int layer, int b, int t) {
    if (layer == 0) return t < NMETA ? p->in[1] + (size_t)t * DM : p->in[0] + ((size_t)b * SEQ + (t - NMETA)) * DM;
    return t < NMETA ? (const float*)(p->ws + WS_HMETA) + ((size_t)b * NMETA + t) * DM : p->out + ((size_t)b * SEQ + (t - NMETA)) * DM;
}
__device__ __forceinline__ float* h_dst(KP p, int b, int t) {
    return t < NMETA ? (float*)(p->ws + WS_HMETA) + ((size_t)b * NMETA + t) * DM : p->out + ((size_t)b * SEQ + (t - NMETA)) * DM;
}

namespace pg8 {
#define PG8_LAS __attribute__((address_space(3)))
typedef unsigned short bf16_t;
typedef short bf16x8 __attribute__((ext_vector_type(8)));
typedef float f32x4 __attribute__((ext_vector_type(4)));
typedef unsigned u32x4 __attribute__((ext_vector_type(4)));
constexpr int BM = 256, BK = 64, HALF = 128, HTB = HALF * BK * 2  , STAGE_BYTES = 8 * HTB, NXCD = 8, WGM = 8;

__host__ __device__ __forceinline__ int lds_byte(int r, int c) { const int st = (r >> 4) * 2 + (c >> 5), rr = r & 15, cc = c & 31, ob = rr * 64 + cc * 2; return st * 1024 + (ob ^ (((ob >> 9) & 1) << 5)); }
__host__ __device__ __forceinline__ void stage_rc(int b, int& R, int& C) { const int st = b / 1024, sb = b % 1024, swz = sb ^ (((sb >> 9) & 1) << 5); R = (st >> 1) * 16 + swz / 64; C = (st & 1) * 32 + (swz % 64) / 2; }
__host__ __device__ __forceinline__ int perm32(int rho) { const int n = rho >> 4, i = rho & 15; return 8 * (i >> 2) + 4 * n + (i & 3); }

struct Unit { int pm, pn; };
struct Gemm { const bf16_t* A; const bf16_t* Bt; };

struct StaticOrder {
    int nM, nN, nwg, G, c;
    __host__ __device__ void init(int M, int N, int G_, int c_) { nM = M / BM; nN = N / BM; nwg = nM * nN; G = G_; c = c_; }
    __host__ __device__ bool next(int i, Unit& u) const {
        const long L = (long)i * G + c; if (L >= nwg) return false;
        int wgid = (int)L; { const int q = nwg / NXCD, r = nwg % NXCD, xcd = wgid % NXCD, off = wgid / NXCD; wgid = (xcd < r ? xcd * (q + 1) : r * (q + 1) + (xcd - r) * q) + off; }
        const int nig = WGM * nN, gid = wgid / nig, fm = gid * WGM, gsz = (nM - fm) < WGM ? (nM - fm) : WGM;
        u.pm = fm + ((wgid % nig) % gsz); u.pn = (wgid % nig) / gsz; return true;
    }
    __device__ __forceinline__ void a_ready(const Unit&) const {}
    __device__ __forceinline__ void done(const Unit&) const {}
};
struct TailOrder {
    StaticOrder in; int nN, last;
    __host__ __device__ void init(int M, int N, int G_, int c_) { in.init(M - BM, N, G_, c_); nN = N / BM; last = M / BM - 1; }
    __host__ __device__ bool next(int i, Unit& u) const { if (in.next(i, u)) return true; const int L = i * in.G + in.c - in.nwg; if (L < nN) { u.pm = last; u.pn = L; return true; } return false; }
    __device__ __forceinline__ void a_ready(const Unit&) const {}
    __device__ __forceinline__ void done(const Unit&) const {}
};


struct EpiStore {
    static constexpr bool PERM = true, AFTER_DRAIN = false;
    bf16_t* O; int ldc;
    __device__ __forceinline__ void operator()(const f32x4 (&acc)[2][2][4][2], const Unit& u, int wr, int wc, int fr, int fq) const {
        const int row0 = u.pm * BM + wr * 64 + fr, col0 = u.pn * BM + wc * 32 + 8 * fq;
#pragma unroll
        for (int ai = 0; ai < 2; ++ai)
#pragma unroll
            for (int m = 0; m < 4; ++m) { bf16_t* rowp = O + (size_t)(row0 + ai * HALF + m * 16) * ldc + col0;
#pragma unroll
                for (int bj = 0; bj < 2; ++bj) { const f32x4 v0 = acc[ai][bj][m][0], v1 = acc[ai][bj][m][1];
                    u32x4 w; w.x = cvt_pk_bf16(v0[0], v0[1]); w.y = cvt_pk_bf16(v0[2], v0[3]); w.z = cvt_pk_bf16(v1[0], v1[1]); w.w = cvt_pk_bf16(v1[2], v1[3]);
                    *(u32x4*)(rowp + bj * HALF) = w; } }
    }
};
struct EpiKV {
    static constexpr bool PERM = true, AFTER_DRAIN = false;
    bf16_t* Kb; bf16_t* Vb;
    __device__ __forceinline__ void operator()(const f32x4 (&acc)[2][2][4][2], const Unit& u, int wr, int wc, int fr, int fq) const {
        const int row0 = u.pm * BM + wr * 64 + fr, d0 = wc * 32 + 8 * fq;
#pragma unroll
        for (int ai = 0; ai < 2; ++ai)
#pragma unroll
            for (int m = 0; m < 4; ++m) { const size_t row = (size_t)(row0 + ai * HALF + m * 16);
#pragma unroll
                for (int bj = 0; bj < 2; ++bj) { const f32x4 v0 = acc[ai][bj][m][0], v1 = acc[ai][bj][m][1];
                    u32x4 w; w.x = cvt_pk_bf16(v0[0], v0[1]); w.y = cvt_pk_bf16(v0[2], v0[3]); w.z = cvt_pk_bf16(v1[0], v1[1]); w.w = cvt_pk_bf16(v1[2], v1[3]);
                    bf16_t* dst = bj == 0 ? Kb + row * 1536 + u.pn * 192 + d0 : Vb + row * 1024 + u.pn * 128 + d0;
                    *(u32x4*)dst = w; } }
    }
};
struct EpiRes {
    static constexpr bool PERM = true, AFTER_DRAIN = false;
    const float* x; const float* meta; float* out; float* hmeta; int layer, g;
    __device__ __forceinline__ void operator()(const f32x4 (&acc)[2][2][4][2], const Unit& u, int wr, int wc, int fr, int fq) const {
        const int row0 = u.pm * BM + wr * 64 + fr, col0 = u.pn * BM + wc * 32 + 8 * fq;
#pragma unroll
        for (int ai = 0; ai < 2; ++ai)
#pragma unroll
            for (int m = 0; m < 4; ++m) { const int lr = row0 + ai * HALF + m * 16;
                if (lr < R) { const int bl = lr / T, t = lr - bl * T, b = g * GB + bl;
                    float* d; const float* s;
                    if (t < NMETA) { d = hmeta + ((size_t)b * NMETA + t) * DM; s = layer == 0 ? meta + (size_t)t * DM : d; }
                    else { const size_t o = ((size_t)b * SEQ + (t - NMETA)) * DM; d = out + o; s = layer == 0 ? x + o : d; }
#pragma unroll
                    for (int bj = 0; bj < 2; ++bj) { const int c = col0 + bj * HALF;
                        const f32x4 a0 = *(const f32x4*)(s + c), a1 = *(const f32x4*)(s + c + 4);
                        *(f32x4*)(d + c) = a0 + acc[ai][bj][m][0]; *(f32x4*)(d + c + 4) = a1 + acc[ai][bj][m][1]; } } }
    }
};
struct EpiGate {
    static constexpr bool PERM = true, AFTER_DRAIN = false;
    const bf16_t* xc; bf16_t* LA; bf16_t* BB; const float* b_a; const float* b_x; const float* lam;
    __device__ __forceinline__ void operator()(const f32x4 (&acc)[2][2][4][2], const Unit& u, int wr, int wc, int fr, int fq) const {
        const int row0 = u.pm * BM + wr * 64 + fr, ch0 = u.pn * 128 + wc * 32 + 8 * fq;
        float ba[8], bx[8], sp[8];
#pragma unroll
        for (int e = 0; e < 8; ++e) { ba[e] = b_a[ch0 + e]; bx[e] = b_x[ch0 + e]; sp[e] = lam[ch0 + e]; }
#pragma unroll
        for (int ai = 0; ai < 2; ++ai)
#pragma unroll
            for (int m = 0; m < 4; ++m) { const size_t row = (size_t)(row0 + ai * HALF + m * 16);
                if (u.pm * BM + wr * 64 + ai * HALF + m * 16 >= R) continue;
                const u32x4 xv = *(const u32x4*)(xc + row * DI + ch0);
                float la2[8], bb[8];
#pragma unroll
                for (int e = 0; e < 8; ++e) { const float ra = acc[ai][0][m][e >> 2][e & 3] + ba[e], ri = acc[ai][1][m][e >> 2][e & 3] + bx[e];
                    const float ea = 1.f + __expf(-ra), ei = 1.f + __expf(-ri), rc = __builtin_amdgcn_rcpf(ea * ei);
                    const float r = rc * ei, ig = rc * ea, l2 = -sp[e] * r;
                    const unsigned xw = xv[e >> 1]; const float xcv = (e & 1) ? bfhi(xw) : bflo(xw);
                    bb[e] = __builtin_amdgcn_sqrtf(fmaxf(1.0f - __builtin_amdgcn_exp2f(2.0f * l2), 0.f)) * ig * xcv; la2[e] = l2; }
                u32x4 w0, w1;
                w0.x = pk_h2(la2[0], la2[1]); w0.y = pk_h2(la2[2], la2[3]); w0.z = pk_h2(la2[4], la2[5]); w0.w = pk_h2(la2[6], la2[7]);
                w1.x = cvt_pk_bf16(bb[0], bb[1]); w1.y = cvt_pk_bf16(bb[2], bb[3]); w1.z = cvt_pk_bf16(bb[4], bb[5]); w1.w = cvt_pk_bf16(bb[6], bb[7]);
                *(u32x4*)(LA + row * DI + ch0) = w0; *(u32x4*)(BB + row * DI + ch0) = w1; }
    }
};

template <int LDA, int LDB, int KK, int APN, class Epi, class Sched, bool ALIGN_EPI = false, bool SP2 = false, int HALFPM = -1>
__device__ __forceinline__ void gemm_phase(PG8_LAS unsigned char* lds, const Gemm g, const Sched& S, const Epi& E, int wv) {
    const int tid = otid(wv), wid = wv, lane = tid & 63, wr = wid >> 2, wc = wid & 3, fr = lane & 15, fq = lane >> 4;
    constexpr int K = KK; int nt = K / BK; asm volatile("" : "+s"(nt));
    unsigned voffA[2], voffB[2];
#pragma unroll
    for (int i = 0; i < 2; ++i) { int R, C; stage_rc(tid * 16 + i * 8192, R, C); const int Rb = Epi::PERM ? ((R & ~31) + perm32(R & 31)) : R;
        voffA[i] = (unsigned)(R * LDA + C) * 2u; voffB[i] = (unsigned)(Rb * LDB + C) * 2u; }
    constexpr size_t kstep = (size_t)(BK * 2);
    constexpr size_t hstepA = (size_t)HALF * LDA * 2, hstepB = (size_t)HALF * LDB * 2;
    constexpr size_t tstepA = 2 * hstepA, tstepB = 2 * hstepB, apn = (size_t)APN * 2;
    const unsigned ldsw = (unsigned)wid * 1024u;
    const int aoff = lds_byte(wr * 64 + fr, fq * 8), boff = lds_byte(wc * 32 + fr, fq * 8);
#define PG8_SA(b, h) (((b) * 2 + (h)) * HTB)
#define PG8_SB(b, h) ((4 + (b) * 2 + (h)) * HTB)
#define PG8_STAGE(bufoff, gbase, voff) do { _Pragma("unroll") for (int _i = 0; _i < 2; ++_i) \
        __builtin_amdgcn_global_load_lds((const unsigned*)((const char*)(gbase) + (voff)[_i]), (PG8_LAS unsigned*)(lds + (bufoff) + ldsw + _i * 8192), 16, 0, 0); } while (0)
#define PG8_LDA(dst, b, h) do { _Pragma("unroll") for (int m = 0; m < 4; ++m) _Pragma("unroll") for (int k = 0; k < 2; ++k) dst[m][k] = *(const PG8_LAS bf16x8*)(lds + PG8_SA(b, h) + aoff + m * 2048 + k * 1024); } while (0)
#define PG8_LDB(dst, b, h) do { _Pragma("unroll") for (int n = 0; n < 2; ++n) _Pragma("unroll") for (int k = 0; k < 2; ++k) dst[n][k] = *(const PG8_LAS bf16x8*)(lds + PG8_SB(b, h) + boff + n * 2048 + k * 1024); } while (0)
#define PG8_MMA(ai, bj, At, Bt) do { __builtin_amdgcn_s_setprio(1); _Pragma("unroll") for (int m = 0; m < 4; ++m) _Pragma("unroll") for (int n = 0; n < 2; ++n) _Pragma("unroll") for (int k = 0; k < 2; ++k) \
        acc[ai][bj][m][n] = __builtin_amdgcn_mfma_f32_16x16x32_bf16(Bt[n][k], At[m][k], acc[ai][bj][m][n], 0, 0, 0); __builtin_amdgcn_s_setprio(0); } while (0)
#define PG8_WAIT_V(n) asm volatile("s_waitcnt vmcnt(" #n ")" ::: "memory")
#define PG8_WAIT_L(n) asm volatile("s_waitcnt lgkmcnt(" #n ")" ::: "memory")
#define PG8_BAR __builtin_amdgcn_s_barrier()
#define PG8_SCHED __builtin_amdgcn_sched_barrier(0)
    Unit cur, nxt; int ui = 0;
    if (!S.next(0, cur)) return;
    f32x4 acc[2][2][4][2];
#pragma unroll
    for (int a = 0; a < 2; ++a)
#pragma unroll
        for (int b = 0; b < 2; ++b)
#pragma unroll
            for (int m = 0; m < 4; ++m)
#pragma unroll
                for (int n = 0; n < 2; ++n) { f32x4 z_ = {0.f, 0.f, 0.f, 0.f}; asm volatile("" : "+v"(z_)); acc[a][b][m][n] = z_; }
    bf16x8 At[4][2], B0[2][2], B1[2][2];
    const char* cA = (const char*)g.A + (size_t)cur.pm * tstepA + (size_t)cur.pn * apn; const char* cB = (const char*)g.Bt + (size_t)cur.pn * tstepB;
    S.a_ready(cur);
    if constexpr (SP2) {
        PG8_STAGE(PG8_SB(0, 0), cB, voffB); PG8_STAGE(PG8_SB(0, 1), cB + hstepB, voffB); PG8_STAGE(PG8_SA(0, 0), cA, voffA); PG8_STAGE(PG8_SA(0, 1), cA + hstepA, voffA);
        if (wr == 1) PG8_BAR;
        PG8_WAIT_V(2); PG8_BAR;
        PG8_STAGE(PG8_SB(1, 0), cB + kstep, voffB); PG8_STAGE(PG8_SA(1, 0), cA + kstep, voffA); PG8_STAGE(PG8_SB(1, 1), cB + hstepB + kstep, voffB);
        PG8_WAIT_V(6); PG8_BAR;
    } else {
        PG8_STAGE(PG8_SB(0, 0), cB, voffB); PG8_STAGE(PG8_SA(0, 0), cA, voffA); PG8_STAGE(PG8_SB(0, 1), cB + hstepB, voffB); PG8_STAGE(PG8_SA(0, 1), cA + hstepA, voffA);
        if (wr == 1) PG8_BAR;
        PG8_WAIT_V(4); PG8_BAR;
        PG8_STAGE(PG8_SB(1, 0), cB + kstep, voffB); PG8_STAGE(PG8_SA(1, 0), cA + kstep, voffA); PG8_STAGE(PG8_SB(1, 1), cB + hstepB + kstep, voffB);
        PG8_WAIT_V(6); PG8_BAR;
    }
    for (;;) {
        const bool has_next = S.next(ui + 1, nxt);
        const char* nA = has_next ? (const char*)g.A + (size_t)nxt.pm * tstepA + (size_t)nxt.pn * apn : cA; const char* nB = has_next ? (const char*)g.Bt + (size_t)nxt.pn * tstepB : cB;
#pragma clang loop unroll(disable)
        for (int t = 0; t < nt; t += 2) {
            const bool last = (t == nt - 2);
            const char* a1 = cA + (size_t)(t + 1) * kstep;
            const char* a2 = last ? nA : cA + (size_t)(t + 2) * kstep; const char* b2 = last ? nB : cB + (size_t)(t + 2) * kstep;
            const char* a3 = a2 + kstep; const char* b3 = b2 + kstep;
            if (last && has_next) S.a_ready(nxt);
            if constexpr (SP2) {
            PG8_LDB(B0, 0, 0); PG8_LDB(B1, 0, 1); PG8_SCHED; PG8_LDA(At, 0, 0); PG8_STAGE(PG8_SA(1, 1), a1 + hstepA, voffA);
            PG8_WAIT_V(8); PG8_WAIT_L(0); PG8_BAR; PG8_MMA(0, 0, At, B0); PG8_MMA(0, 1, At, B1); PG8_BAR; PG8_SCHED;
            PG8_LDA(At, 0, 1); PG8_STAGE(PG8_SB(0, 0), b2, voffB); PG8_STAGE(PG8_SB(0, 1), b2 + hstepB, voffB); PG8_STAGE(PG8_SA(0, 0), a2, voffA);
            PG8_WAIT_V(8); PG8_WAIT_L(0); PG8_BAR; if (HALFPM < 0 || cur.pm != HALFPM) { PG8_MMA(1, 0, At, B0); PG8_MMA(1, 1, At, B1); } PG8_BAR; PG8_SCHED;
            PG8_LDB(B0, 1, 0); PG8_LDB(B1, 1, 1); PG8_SCHED; PG8_LDA(At, 1, 0); PG8_STAGE(PG8_SA(0, 1), a2 + hstepA, voffA);
            PG8_WAIT_V(8); PG8_WAIT_L(0); PG8_BAR; PG8_MMA(0, 0, At, B0); PG8_MMA(0, 1, At, B1); PG8_BAR; PG8_SCHED;
            PG8_LDA(At, 1, 1); PG8_STAGE(PG8_SB(1, 0), b3, voffB); PG8_STAGE(PG8_SB(1, 1), b3 + hstepB, voffB); PG8_STAGE(PG8_SA(1, 0), a3, voffA);
            PG8_WAIT_V(8); PG8_WAIT_L(0); PG8_BAR; if (HALFPM < 0 || cur.pm != HALFPM) { PG8_MMA(1, 0, At, B0); PG8_MMA(1, 1, At, B1); } PG8_BAR; PG8_SCHED;
            } else {
            PG8_LDB(B0, 0, 0); PG8_SCHED; PG8_LDA(At, 0, 0); PG8_STAGE(PG8_SA(1, 1), a1 + hstepA, voffA);
            PG8_WAIT_L(8); PG8_BAR; PG8_WAIT_L(0); PG8_MMA(0, 0, At, B0); PG8_BAR; PG8_SCHED;
            PG8_LDB(B1, 0, 1); PG8_STAGE(PG8_SB(0, 0), b2, voffB);
            PG8_BAR; PG8_WAIT_L(0); PG8_MMA(0, 1, At, B1); PG8_BAR;
            PG8_LDA(At, 0, 1); PG8_STAGE(PG8_SA(0, 0), a2, voffA);
            PG8_BAR; PG8_WAIT_L(0); PG8_MMA(1, 0, At, B0); PG8_BAR; PG8_SCHED;
            PG8_STAGE(PG8_SB(0, 1), b2 + hstepB, voffB);
            PG8_WAIT_V(6); PG8_BAR; PG8_MMA(1, 1, At, B1); PG8_BAR;
            PG8_LDB(B0, 1, 0); PG8_SCHED; PG8_LDA(At, 1, 0); PG8_STAGE(PG8_SA(0, 1), a2 + hstepA, voffA);
            PG8_WAIT_L(8); PG8_BAR; PG8_WAIT_L(0); PG8_MMA(0, 0, At, B0); PG8_BAR; PG8_SCHED;
            PG8_LDB(B1, 1, 1); PG8_STAGE(PG8_SB(1, 0), b3, voffB);
            PG8_BAR; PG8_WAIT_L(0); PG8_MMA(0, 1, At, B1); PG8_BAR;
            PG8_LDA(At, 1, 1); PG8_STAGE(PG8_SA(1, 0), a3, voffA);
            PG8_BAR; PG8_WAIT_L(0); PG8_MMA(1, 0, At, B0); PG8_BAR; PG8_SCHED;
            PG8_STAGE(PG8_SB(1, 1), b3 + hstepB, voffB);
            PG8_WAIT_V(6); PG8_BAR; PG8_MMA(1, 1, At, B1); PG8_BAR;
            }
        }
        if constexpr (ALIGN_EPI) { if (wr == 0) PG8_BAR; }
        if constexpr (!Epi::AFTER_DRAIN) { E(acc, cur, wr, wc, fr, fq); S.done(cur); }
        if (!has_next) break;
#pragma unroll
        for (int a = 0; a < 2; ++a)
#pragma unroll
            for (int b = 0; b < 2; ++b)
#pragma unroll
                for (int m = 0; m < 4; ++m)
#pragma unroll
                    for (int n = 0; n < 2; ++n) { f32x4 z_ = {0.f, 0.f, 0.f, 0.f}; asm volatile("" : "+v"(z_)); acc[a][b][m][n] = z_; }
        cur = nxt; cA = nA; cB = nB; ++ui;
        if constexpr (ALIGN_EPI) { if (wr == 1) PG8_BAR; }
    }
    PG8_WAIT_V(0);
    if constexpr (!ALIGN_EPI) { if (wr == 0) PG8_BAR; }
    PG8_BAR;
    if constexpr (Epi::AFTER_DRAIN) { E.fused(acc, cur, wr, wc, fr, fq, lds, wid, lane); S.done(cur); }
#undef PG8_SA
#undef PG8_SB
#undef PG8_STAGE
#undef PG8_LDA
#undef PG8_LDB
#undef PG8_MMA
#undef PG8_WAIT_V
#undef PG8_WAIT_L
#undef PG8_BAR
#undef PG8_SCHED
}
}

namespace att {
constexpr int NW = 8, QBLK = 32, KVBLK = 64;
constexpr float THR = 8.f;
#define SBAR() __builtin_amdgcn_sched_barrier(0)
__device__ __forceinline__ int crow(int r, int hi) { return (r & 3) + 8 * (r >> 2) + 4 * hi; }
__device__ __forceinline__ unsigned cvtpk(float lo, float hi) { unsigned r; asm volatile("v_cvt_pk_bf16_f32 %0, %1, %2" : "=v"(r) : "v"(lo), "v"(hi)); return r; }

template <int DQK> struct Cfg {
    static constexpr float SCALE = DQK == 192 ? 0.07216878364870322f : 0.08838834764831845f;
    static constexpr int KROWB = DQK * 2, SHM_V = KVBLK * 128 * 2, SHM_K = KVBLK * DQK * 2, KC = DQK / 64, ND0 = DQK / 16;
    static constexpr int NKA = DQK == 128 ? 1 : 4;
    static __device__ __forceinline__ int fsw(int r) { return DQK == 128 ? (r & 15) : ((r >> 1) & 7); }
    static constexpr int OFF_K = 3 * SHM_V, OFF_WS = 3 * SHM_V + 2 * SHM_K, LDS_NEED = OFF_WS + NW * 64 * 4;
};

template <int DQK>
__device__ __forceinline__ void partialSM(f32x16& p0, f32x16& p1, float& m_reg, float& mn, float& alpha) {
    constexpr float SCALE = Cfg<DQK>::SCALE, C = SCALE * 1.4426950408889634f;
    float pmax = p0[0];
#pragma unroll
    for (int r = 1; r < 16; ++r) pmax = fmaxf(pmax, p0[r]);
#pragma unroll
    for (int r = 0; r < 16; ++r) pmax = fmaxf(pmax, p1[r]);
    { auto rr = __builtin_amdgcn_permlane32_swap(__float_as_uint(pmax), __float_as_uint(pmax), false, false);
      pmax = fmaxf(__uint_as_float(rr[0]), __uint_as_float(rr[1])); }
    if (__builtin_expect(__all(pmax - m_reg <= THR / SCALE), 1)) { mn = m_reg; alpha = 1.f; }
    else { mn = fmaxf(m_reg, pmax); alpha = __builtin_amdgcn_exp2f((m_reg - mn) * C); m_reg = mn; }
    const float mnC = -mn * C;
#pragma unroll
    for (int r = 0; r < 16; ++r) p0[r] = fmaf(p0[r], C, mnC);
#pragma unroll
    for (int r = 0; r < 16; ++r) p1[r] = fmaf(p1[r], C, mnC);
#pragma unroll
    for (int r = 0; r < 16; ++r) p0[r] = __builtin_amdgcn_exp2f(p0[r]);
}
__device__ __forceinline__ void finishSM(f32x16& p0, f32x16& p1, float alpha, float& l_reg, bf16x8& pa0, bf16x8& pa1, bf16x8& pa2, bf16x8& pa3) {
#pragma unroll
    for (int r = 0; r < 16; ++r) p1[r] = __builtin_amdgcn_exp2f(p1[r]);
    float ps = 0;
#pragma unroll
    for (int r = 0; r < 16; ++r) ps += p0[r];
#pragma unroll
    for (int r = 0; r < 16; ++r) ps += p1[r];
    { auto rr = __builtin_amdgcn_permlane32_swap(__float_as_uint(ps), __float_as_uint(ps), false, false);
      ps = __uint_as_float(rr[0]) + __uint_as_float(rr[1]); }
    l_reg = l_reg * alpha + ps;
#define PK4(P, BASE, OUT) do { unsigned a0 = cvtpk(P[BASE + 0], P[BASE + 1]), a1 = cvtpk(P[BASE + 2], P[BASE + 3]);   \
    unsigned b0 = cvtpk(P[BASE + 4], P[BASE + 5]), b1 = cvtpk(P[BASE + 6], P[BASE + 7]);                              \
    auto r0 = __builtin_amdgcn_permlane32_swap(a0, b0, false, false); auto r1 = __builtin_amdgcn_permlane32_swap(a1, b1, false, false); \
    u32x4 w = {r0[0], r1[0], r0[1], r1[1]}; OUT = *reinterpret_cast<bf16x8*>(&w); } while (0)
    PK4(p0, 0, pa0); PK4(p0, 8, pa1); PK4(p1, 0, pa2); PK4(p1, 8, pa3);
#undef PK4
}
template <int DQK>
__device__ __forceinline__ void qkt(f32x16& p0, f32x16& p1, const char* Ks, const bf16x8* qr, const int (&ka)[Cfg<DQK>::NKA], int r32) {
    constexpr int KROWB = Cfg<DQK>::KROWB;
    { f32x16 z = {}; asm volatile("" : "+v"(z)); p0 = z; p1 = z; }
    int kf = DQK == 128 ? (r32 & 14) : 0; if (DQK == 128) asm volatile("" : "+v"(kf));
#define KOFF(d0_) (DQK == 128 ? ka[0] + (((2 * (d0_)) ^ kf) << 4) : ka[(d0_) & 3] + ((d0_) >> 2) * 128)
    bf16x8 c0 = *reinterpret_cast<const bf16x8*>(Ks + KOFF(0)), c1 = *reinterpret_cast<const bf16x8*>(Ks + KOFF(0) + 32 * KROWB);
#pragma unroll
    for (int d0 = 0; d0 < Cfg<DQK>::ND0; ++d0) {
        bf16x8 n0 = c0, n1 = c1;
        if (d0 + 1 < Cfg<DQK>::ND0) { n0 = *reinterpret_cast<const bf16x8*>(Ks + KOFF(d0 + 1)); n1 = *reinterpret_cast<const bf16x8*>(Ks + KOFF(d0 + 1) + 32 * KROWB); }
        p0 = __builtin_amdgcn_mfma_f32_32x32x16_bf16(c0, qr[d0], p0, 0, 0, 0);
        p1 = __builtin_amdgcn_mfma_f32_32x32x16_bf16(c1, qr[d0], p1, 0, 0, 0);
        c0 = n0; c1 = n1; }
#undef KOFF
}
__device__ __forceinline__ int v_st(int k, int c) { const int kk = (k & ~0xC) | ((k & 4) << 1) | ((k & 8) >> 1); return ((kk >> 3) * 4 + (c >> 5)) * 512 + ((kk & 7) * 32 + (c & 31)) * 2; }
__device__ __forceinline__ int v_rd_base(int lane) { return ((lane & 3) << 3) | (((lane >> 2) & 3) << 6) | (((lane >> 4) & 1) << 5) | (((lane >> 5) & 1) << 8); }
constexpr int v_rd_off(int d0, int ks, int half) { return d0 * 512 + ks * 4096 + half * 2048; }
template <int OFF> __device__ __forceinline__ s16x4 tr_read(int vb) {
    s16x4 r; asm volatile("ds_read_b64_tr_b16 %0, %1 offset:%2" : "=&v"(r) : "v"(vb), "i"(OFF) : "memory"); return r;
}
template <int D0> __device__ __forceinline__ void pv_one(f32x16& od, int vb, bf16x8 pa0, bf16x8 pa1, bf16x8 pa2, bf16x8 pa3) {
    const s16x4 l0 = tr_read<v_rd_off(D0, 0, 0)>(vb), h0 = tr_read<v_rd_off(D0, 0, 1)>(vb), l1 = tr_read<v_rd_off(D0, 1, 0)>(vb), h1 = tr_read<v_rd_off(D0, 1, 1)>(vb);
    const s16x4 l2 = tr_read<v_rd_off(D0, 2, 0)>(vb), h2 = tr_read<v_rd_off(D0, 2, 1)>(vb), l3 = tr_read<v_rd_off(D0, 3, 0)>(vb), h3 = tr_read<v_rd_off(D0, 3, 1)>(vb);
    asm volatile("s_waitcnt lgkmcnt(0)" ::: "memory"); SBAR();
#define PK(L, H) (bf16x8){L[0], L[1], L[2], L[3], H[0], H[1], H[2], H[3]}
    od = __builtin_amdgcn_mfma_f32_32x32x16_bf16(pa0, PK(l0, h0), od, 0, 0, 0);
    od = __builtin_amdgcn_mfma_f32_32x32x16_bf16(pa1, PK(l1, h1), od, 0, 0, 0);
    od = __builtin_amdgcn_mfma_f32_32x32x16_bf16(pa2, PK(l2, h2), od, 0, 0, 0);
    od = __builtin_amdgcn_mfma_f32_32x32x16_bf16(pa3, PK(l3, h3), od, 0, 0, 0);
#undef PK
}
__device__ __forceinline__ void pv_d0(f32x16* o, int vb, bf16x8 pa0, bf16x8 pa1, bf16x8 pa2, bf16x8 pa3) {
    pv_one<0>(o[0], vb, pa0, pa1, pa2, pa3); pv_one<1>(o[1], vb, pa0, pa1, pa2, pa3); pv_one<2>(o[2], vb, pa0, pa1, pa2, pa3); pv_one<3>(o[3], vb, pa0, pa1, pa2, pa3);
}
template <bool SWA>
__device__ __forceinline__ void mask_tile(f32x16& p0, f32x16& p1, int k0, int klo, int tq, int hi) {
#pragma unroll
    for (int r = 0; r < 16; ++r) {
        const int tk0 = k0 + crow(r, hi), tk1 = tk0 + 32;
        bool ok0 = tk0 >= klo, ok1 = tk1 >= klo;
        if (SWA) { const int d0 = tq - tk0, d1 = tq - tk1;
            ok0 = ok0 && (tk0 < NMETA || (d0 <= 128 && d0 >= -128)); ok1 = ok1 && (tk1 < NMETA || (d1 <= 128 && d1 >= -128)); }
        if (!ok0) p0[r] = -1e30f;
        if (!ok1) p1[r] = -1e30f;
    }
}

template <int DQK, int LDQ, int LDK, int LDV, bool SWA>
__device__ __forceinline__ void attn_unit(const bf16_t* __restrict__ Qb, const bf16_t* __restrict__ Kh, const bf16_t* __restrict__ Vh, bf16_t* Yg,
                                          int i0, int NT, int tfirst, float m_init, float l_init, char* lds, LAS unsigned char* ldsl, int wv, bool dostore, const float* gq) {
    using C = Cfg<DQK>;
    constexpr int SHM_V = C::SHM_V, SHM_K = C::SHM_K, KC = C::KC, KROWB = C::KROWB;
    const int tid = otid(wv), wid = wv, lane = tid & 63, r32 = lane & 31, hi = lane >> 5;
    char* V_lds = lds; char* K_lds = lds + C::OFF_K;
    float* wsp = (float*)(lds + C::OFF_WS) + wid * 64; float* li_l = wsp; float* al_l = wsp + 32;
    float m_reg = m_init, l_reg = l_init; f32x16 o[4]; bf16x8 qr[C::ND0];
#pragma unroll
    for (int d = 0; d < 4; ++d) { f32x16 z_ = {}; asm volatile("" : "+v"(z_)); o[d] = z_; }
    const int tq = i0 + wid * QBLK + r32;
    const bool wactive = i0 + wid * QBLK < T;
    { const int tqc = tq < T ? tq : T - 1; const bf16_t* Qw = Qb + (size_t)tqc * LDQ + hi * 8;
#pragma unroll
      for (int d0 = 0; d0 < C::ND0; ++d0) qr[d0] = *reinterpret_cast<const bf16x8*>(Qw + d0 * 16); }
    if constexpr (!SWA) {
        const int tqc = tq < T ? tq : T - 1;
        float ss = 0.f;
#pragma unroll
        for (int d0 = 0; d0 < C::ND0; ++d0) { const u32x4 w = __builtin_bit_cast(u32x4, qr[d0]);
#pragma unroll
            for (int e = 0; e < 4; ++e) { const float a = bflo(w[e]), b = bfhi(w[e]); ss += a * a + b * b; } }
        { auto rr = __builtin_amdgcn_permlane32_swap(__float_as_uint(ss), __float_as_uint(ss), false, false); ss = __uint_as_float(rr[0]) + __uint_as_float(rr[1]); }
        const float rstd = rsqrtf(ss * (1.f / 192.f) + EPS);
#pragma unroll
        for (int d0 = 0; d0 < 8; ++d0) { const u32x4 w = __builtin_bit_cast(u32x4, qr[d0]); const f32x4 g0 = *(const f32x4*)(gq + d0 * 16 + hi * 8), g1 = *(const f32x4*)(gq + d0 * 16 + hi * 8 + 4);
            u32x4 o_; o_[0] = cvtpk(bflo(w[0]) * rstd * g0[0], bfhi(w[0]) * rstd * g0[1]); o_[1] = cvtpk(bflo(w[1]) * rstd * g0[2], bfhi(w[1]) * rstd * g0[3]);
            o_[2] = cvtpk(bflo(w[2]) * rstd * g1[0], bfhi(w[2]) * rstd * g1[1]); o_[3] = cvtpk(bflo(w[3]) * rstd * g1[2], bfhi(w[3]) * rstd * g1[3]);
            qr[d0] = __builtin_bit_cast(bf16x8, o_); }
#pragma unroll
        for (int dd = 0; dd < 2; ++dd) { const u32x4 w1 = __builtin_bit_cast(u32x4, qr[8 + dd]), w2 = __builtin_bit_cast(u32x4, qr[10 + dd]);
            float y1[8], y2[8];
#pragma unroll
            for (int e = 0; e < 8; ++e) { const int ci = dd * 16 + hi * 8 + e;
                const float x1 = (e & 1) ? bfhi(w1[e >> 1]) : bflo(w1[e >> 1]), x2 = (e & 1) ? bfhi(w2[e >> 1]) : bflo(w2[e >> 1]);
                const float a1 = x1 * rstd * gq[128 + ci], a2 = x2 * rstd * gq[160 + ci];
                float sn, cs; sincosf((float)tqc * exp2f(-(float)(2 * ci) * (13.287712379549449f / 64.f)), &sn, &cs);
                y1[e] = a1 * cs - a2 * sn; y2[e] = a1 * sn + a2 * cs; }
            u32x4 o1, o2;
#pragma unroll
            for (int e = 0; e < 4; ++e) { o1[e] = cvtpk(y1[2 * e], y1[2 * e + 1]); o2[e] = cvtpk(y2[2 * e], y2[2 * e + 1]); }
            qr[8 + dd] = __builtin_bit_cast(bf16x8, o1); qr[10 + dd] = __builtin_bit_cast(bf16x8, o2); }
    }
    unsigned koff[KC], voff[2];
#pragma unroll
    for (int i = 0; i < KC; ++i) { const int c = (wid * KC + i) * 64 + lane, row = c / (DQK / 8), pos = c % (DQK / 8); koff[i] = (unsigned)(row * LDK + (pos ^ C::fsw(row)) * 8); }
#pragma unroll
    for (int i = 0; i < 2; ++i) { const int o16 = ((wid * 2 + i) * 64 + lane) * 16, sub = o16 >> 9, within = o16 & 511, kk = (sub >> 2) * 8 + (within >> 6);
        const int vr = (kk & ~0xC) | ((kk & 4) << 1) | ((kk & 8) >> 1); voff[i] = (unsigned)(vr * LDV + (sub & 3) * 32 + ((within & 63) >> 1)); }
    int ka[C::NKA];
#pragma unroll
    for (int q4 = 0; q4 < C::NKA; ++q4) ka[q4] = r32 * KROWB + ((q4 * 32 + hi * 16) ^ (C::fsw(r32) << 4));
    if (DQK == 128) ka[0] = r32 * KROWB + ((hi ^ (r32 & 1)) << 4);
    const int vb0 = (int)(uintptr_t)V_lds + v_rd_base(lane);
    const bool hasmeta = SWA && tfirst > 0;
#define TKOFF(j) (SWA ? ((hasmeta && (j) == 0) ? 0 : (tfirst + (j) - (hasmeta ? 1 : 0)) * KVBLK) : (j) * KVBLK)
#define KA(j) (TKOFF(j) < T - KVBLK ? TKOFF(j) : T - KVBLK)
#define DMA(j_, ks_, vs_) do { const int k0__ = KA(j_); const bf16_t* kt_ = Kh + (size_t)k0__ * LDK; const bf16_t* vt_ = Vh + (size_t)k0__ * LDV; \
    _Pragma("unroll") for (int i = 0; i < KC; ++i) \
        __builtin_amdgcn_global_load_lds((const unsigned*)(kt_ + koff[i]), (LAS unsigned*)(ldsl + C::OFF_K + (ks_) * SHM_K + (wid * KC + i) * 1024), 16, 0, 0); \
    _Pragma("unroll") for (int i = 0; i < 2; ++i) \
        __builtin_amdgcn_global_load_lds((const unsigned*)(vt_ + voff[i]), (LAS unsigned*)(ldsl + (vs_) * SHM_V + (wid * 2 + i) * 1024), 16, 0, 0); } while (0)
#define LANDED() do { asm volatile("s_waitcnt vmcnt(0)" ::: "memory"); __syncthreads(); } while (0)
#define RESC(a) do { if (__any((a) < 1.f)) { if (hi == 0) al_l[r32] = (a); asm volatile("s_waitcnt lgkmcnt(0)" ::: "memory"); \
    _Pragma("unroll") for (int d = 0; d < 4; ++d) _Pragma("unroll") for (int r = 0; r < 16; ++r) o[d][r] *= al_l[crow(r, hi)]; } } while (0)
#define MASK(P0, P1, j) do { const int k0m = TKOFF(j); if (SWA || k0m + KVBLK > T) { int hi_ = hi; asm volatile("" : "+v"(hi_)); mask_tile<SWA>(P0, P1, KA(j), k0m, tq, hi_); } } while (0)
    f32x16 pA0, pA1, pB0, pB1; float mnA, mnB, alA, alB; bf16x8 pa0, pa1, pa2, pa3;
    if constexpr (SWA) {
        const int w0 = i0 + wid * QBLK;
        DMA(0, 0, 0); LANDED();
        for (int j = 0; j < NT; ++j) {
            const int sl = j & 1, k0n = TKOFF(j);
            if (j + 1 < NT) DMA(j + 1, sl ^ 1, sl ^ 1);
            if (wactive && (k0n == 0 || (k0n + KVBLK > w0 - 128 && k0n <= w0 + QBLK - 1 + 128))) {
                SBAR(); qkt<DQK>(pA0, pA1, K_lds + sl * SHM_K, qr, ka, r32);
                MASK(pA0, pA1, j); partialSM<DQK>(pA0, pA1, m_reg, mnA, alA);
                RESC(alA);
                finishSM(pA0, pA1, alA, l_reg, pa0, pa1, pa2, pa3); SBAR();
                pv_d0(o, vb0 + sl * SHM_V, pa0, pa1, pa2, pa3); }
            LANDED();
        }
    } else {
    DMA(0, 0, 0); LANDED();
    DMA(1, 1, 1);
    if (wactive) { qkt<DQK>(pA0, pA1, K_lds, qr, ka, r32); MASK(pA0, pA1, 0); partialSM<DQK>(pA0, pA1, m_reg, mnA, alA); }
    LANDED();
    int vprev = 0, vnext = 2;
    for (int j = 1; j + 1 < NT; j += 2) {
        DMA(j + 1, 0, vnext);
        if (wactive) { SBAR(); qkt<DQK>(pB0, pB1, K_lds + SHM_K, qr, ka, r32);
            finishSM(pA0, pA1, alA, l_reg, pa0, pa1, pa2, pa3); SBAR();
            pv_d0(o, vb0 + vprev * SHM_V, pa0, pa1, pa2, pa3); MASK(pB0, pB1, j); partialSM<DQK>(pB0, pB1, m_reg, mnB, alB);
            RESC(alB); }
        LANDED();
        vprev = vprev == 2 ? 0 : vprev + 1; vnext = vnext == 2 ? 0 : vnext + 1;
        DMA(j + 2, 1, vnext);
        if (wactive) { SBAR(); qkt<DQK>(pA0, pA1, K_lds, qr, ka, r32);
            finishSM(pB0, pB1, alB, l_reg, pa0, pa1, pa2, pa3); SBAR();
            pv_d0(o, vb0 + vprev * SHM_V, pa0, pa1, pa2, pa3); MASK(pA0, pA1, j + 1); partialSM<DQK>(pA0, pA1, m_reg, mnA, alA);
            RESC(alA); }
        LANDED();
        vprev = vprev == 2 ? 0 : vprev + 1; vnext = vnext == 2 ? 0 : vnext + 1;
    }
    if (wactive) {
        const int vb0t = (int)(uintptr_t)V_lds + v_rd_base(olane());
        SBAR(); qkt<DQK>(pB0, pB1, K_lds + SHM_K, qr, ka, r32);
        finishSM(pA0, pA1, alA, l_reg, pa0, pa1, pa2, pa3); SBAR();
        pv_d0(o, vb0t + vprev * SHM_V, pa0, pa1, pa2, pa3); MASK(pB0, pB1, NT - 1); partialSM<DQK>(pB0, pB1, m_reg, mnB, alB);
        RESC(alB);
        vprev = vprev == 2 ? 0 : vprev + 1;
        finishSM(pB0, pB1, alB, l_reg, pa0, pa1, pa2, pa3); SBAR();
        pv_d0(o, vb0t + vprev * SHM_V, pa0, pa1, pa2, pa3);
    }
    }
    if (hi == 0) li_l[r32] = l_reg; asm volatile("s_waitcnt lgkmcnt(0)" ::: "memory");
    const int le = olane(), r32e = le & 31, hie = le >> 5;
    float rli[16]; { const float* lib = li_l + 4 * hie;
#pragma unroll
    for (int r = 0; r < 16; ++r) rli[r] = __builtin_amdgcn_rcpf(lib[(r & 3) + 8 * (r >> 2)]); }
    __syncthreads();
    {
      bf16_t* stg = (bf16_t*)(lds + wid * (32 * 136 * 2)); bf16_t* stw = stg + hie * 4 * 136 + r32e;
#pragma unroll
      for (int r = 0; r < 16; ++r) { const int rowc = (r & 3) + 8 * (r >> 2);
#pragma unroll
          for (int d0 = 0; d0 < 4; ++d0) stw[rowc * 136 + d0 * 32] = f2bf(o[d0][r] * rli[r]); }
      asm volatile("s_waitcnt lgkmcnt(0)" ::: "memory");
#pragma unroll 1
      for (int half = 0; half < 2; ++half) {
          u32x4 gv[4], ov[4];
#pragma unroll
          for (int i4 = 0; i4 < 4; ++i4) { const int idx = (half * 4 + i4) * 64 + le, row = idx >> 4, c8 = (idx & 15) * 8, trow = i0 + wid * QBLK + row;
              ov[i4] = *(const u32x4*)(stg + row * 136 + c8);
              gv[i4] = (trow < T && dostore) ? *(const u32x4*)(Yg + (size_t)trow * EINP + c8) : (u32x4){0u, 0u, 0u, 0u}; }
#pragma unroll
          for (int i4 = 0; i4 < 4; ++i4) { const int idx = (half * 4 + i4) * 64 + le, row = idx >> 4, c8 = (idx & 15) * 8, trow = i0 + wid * QBLK + row;
              if (trow < T && dostore) { u32x4 w;
#pragma unroll
                  for (int e = 0; e < 4; ++e) w[e] = cvt_pk_bf16(bflo(ov[i4][e]) * siluf_(bflo(gv[i4][e])), bfhi(ov[i4][e]) * siluf_(bfhi(gv[i4][e])));
                  *(u32x4*)(Yg + (size_t)trow * EINP + c8) = w; } } } }
    __syncthreads();
#undef TKOFF
#undef KA
#undef DMA
#undef LANDED
#undef RESC
#undef MASK
}
}

__device__ __forceinline__ void xpose_item(const float* W, int K, int N, bf16_t* WT, float* scr, int item, int lane) {
    const int nblk = N / 32, kb = item / nblk, nb = item % nblk, k0 = 64 * kb, n0 = 32 * nb;
#pragma unroll 8
    for (int i = 0; i < 32; ++i) { const int kk = 2 * i + (lane >> 5); scr[kk * 33 + (lane & 31)] = W[(size_t)(k0 + kk) * N + n0 + (lane & 31)]; }
    asm volatile("s_waitcnt lgkmcnt(0)" ::: "memory");
    const int c = lane & 7;
#pragma unroll
    for (int j = 0; j < 4; ++j) { const int n = (lane >> 3) + 8 * j; const float* s = scr + (8 * c) * 33 + n;
        u32x4 o; o.x = cvt_pk_bf16(s[0 * 33], s[1 * 33]); o.y = cvt_pk_bf16(s[2 * 33], s[3 * 33]); o.z = cvt_pk_bf16(s[4 * 33], s[5 * 33]); o.w = cvt_pk_bf16(s[6 * 33], s[7 * 33]);
        *(u32x4*)(WT + (size_t)(n0 + n) * K + k0 + 8 * c) = o; }
    asm volatile("s_waitcnt lgkmcnt(0)" ::: "memory");
}
__device__ __forceinline__ void xpose_job(const float* W, int K, int N, bf16_t* WT, float* scr, int gw, int nw, int lane) {
    const int items = (K / 64) * (N / 32);
    for (int it = gw; it < items; it += nw) xpose_item(W, K, N, WT, scr, it, lane);
}
__device__ __forceinline__ void phase_weights(KP p, char* lds, int wv) {
    asm volatile("" : "+s"(p));
    const int tid = otid(wv), lane = tid & 63, wid = wv, gw = obid() * NWAVES + wid, nw = gridDim.x * NWAVES;
    float* scr = (float*)lds + wid * (64 * 33);
    unsigned char* ws = p->ws;
    for (int j = 0; j < 2; ++j) {
        xpose_job(p->in[3] + (size_t)j * DM * EIN, DM, EIN, (bf16_t*)(ws + WS_WINE) + (size_t)j * EINP * DM, scr, gw, nw, lane);
        xpose_job(p->in[6] + (size_t)j * 384 * 1536, 384, 1536, (bf16_t*)(ws + WS_WUQ) + (size_t)j * 1536 * 384, scr, gw, nw, lane);
        xpose_job(p->in[7] + (size_t)j * 256 * 2048, 256, 2048, (bf16_t*)(ws + WS_WUKV) + (size_t)j * 2048 * 256, scr, gw, nw, lane);
        xpose_job(p->in[13] + (size_t)j * DI * DM, DI, DM, (bf16_t*)(ws + WS_WOUTE) + (size_t)j * DM * DI, scr, gw, nw, lane);
        xpose_job(p->in[14] + (size_t)j * DM * OIN, DM, OIN, (bf16_t*)(ws + WS_WINO) + (size_t)j * OIN * DM, scr, gw, nw, lane);
        xpose_job(p->in[22] + (size_t)j * DI * DM, DI, DM, (bf16_t*)(ws + WS_WOUTO) + (size_t)j * DM * DI, scr, gw, nw, lane);
        for (int it = gw; it < 64 * 8; it += nw) { const int mat = it >> 3, sub = it & 7, dn = mat >> 1, gate = mat & 1;
            const float* src = (gate ? p->in[19] : p->in[17]) + ((size_t)j * 32 + dn) * 16384;
            bf16_t* dst = (bf16_t*)(ws + WS_WG) + (((size_t)j * 32 + dn) * 256 + gate * 128) * 128;
            xpose_item(src, 128, 128, dst, scr, sub, lane); }
        { float* spt = (float*)(ws + WS_SP) + (size_t)j * 2 * DI; const float* lamp = p->in[21] + (size_t)j * 2 * DI;
          for (int i = obid() * NTHR + tid; i < 2 * DI; i += gridDim.x * NTHR) spt[i] = 8.0f * log1pf(__expf(-lamp[i])) * 1.4426950408889634f; }
        { bf16_t* padp = (bf16_t*)(ws + WS_WINE) + (size_t)j * EINP * DM + (size_t)EIN * DM;
          for (int i = obid() * NTHR + tid; i < (EINP - EIN) * DM / 8; i += gridDim.x * NTHR) *(u32x4*)(padp + (size_t)i * 8) = (u32x4){0u, 0u, 0u, 0u}; }
    }
}
__device__ __forceinline__ void phase_norm(KP p, int layer, int g, int wv) {
    asm volatile("" : "+s"(p));
    const int tid = otid(wv), lane = tid & 63, gw = obid() * NWAVES + wv, nw = gridDim.x * NWAVES;
    const float* gn = p->in[2] + (size_t)layer * DM; bf16_t* z = (bf16_t*)(p->ws + A_Z);
    f32x4 gv[4];
#pragma unroll
    for (int j = 0; j < 4; ++j) gv[j] = *(const f32x4*)(gn + lane * 4 + 256 * j);
    const int nq = (R / 4 / nw) * nw;
    for (int lr = nq * 4 + gw; lr < R; lr += nw) {
        const int bl = lr / T, t = lr - bl * T; const float* src = h_src(p, layer, g * GB + bl, t);
        f32x4 v1[4]; float s1 = 0.f;
#pragma unroll
        for (int j = 0; j < 4; ++j) { v1[j] = *(const f32x4*)(src + lane * 4 + 256 * j); s1 += (v1[j].x * v1[j].x + v1[j].y * v1[j].y) + (v1[j].z * v1[j].z + v1[j].w * v1[j].w); }
        const float rstd = rsqrtf(wave_sum(s1) * (1.f / DM) + EPS);
#pragma unroll
        for (int j = 0; j < 4; ++j) { u32x2 o; o.x = cvt_pk_bf16(v1[j].x * rstd * gv[j].x, v1[j].y * rstd * gv[j].y); o.y = cvt_pk_bf16(v1[j].z * rstd * gv[j].z, v1[j].w * rstd * gv[j].w);
            *(u32x2*)(z + (size_t)lr * DM + lane * 4 + 256 * j) = o; }
    }
    for (int q = gw; q < nq; q += nw) {
        f32x4 v[4][4]; float s[4];
#pragma unroll
        for (int k = 0; k < 4; ++k) { const int lr = q * 4 + k, bl = lr / T, t = lr - bl * T; const float* src = h_src(p, layer, g * GB + bl, t);
#pragma unroll
            for (int j = 0; j < 4; ++j) v[k][j] = *(const f32x4*)(src + lane * 4 + 256 * j); }
#pragma unroll
        for (int k = 0; k < 4; ++k) { s[k] = 0.f;
#pragma unroll
            for (int j = 0; j < 4; ++j) s[k] += (v[k][j].x * v[k][j].x + v[k][j].y * v[k][j].y) + (v[k][j].z * v[k][j].z + v[k][j].w * v[k][j].w); }
#pragma unroll
        for (int k = 0; k < 4; ++k) { const float rstd = rsqrtf(wave_sum(s[k]) * (1.f / DM) + EPS); const int lr = q * 4 + k;
#pragma unroll
            for (int j = 0; j < 4; ++j) { u32x2 o; o.x = cvt_pk_bf16(v[k][j].x * rstd * gv[j].x, v[k][j].y * rstd * gv[j].y); o.y = cvt_pk_bf16(v[k][j].z * rstd * gv[j].z, v[k][j].w * rstd * gv[j].w);
                *(u32x2*)(z + (size_t)lr * DM + lane * 4 + 256 * j) = o; } }
    }
}
__device__ __forceinline__ void phase_prep_even(KP p, int j, int g, int wv) {
    asm volatile("" : "+s"(p));
    const int tid = otid(wv), lane = tid & 63, gw = obid() * NWAVES + wv, nw = gridDim.x * NWAVES;
    bf16_t* zp = (bf16_t*)(p->ws + A_ZP); bf16_t* cqn = (bf16_t*)(p->ws + A_CQN); bf16_t* ckvn = (bf16_t*)(p->ws + A_CKVN);
    const float* gq = p->in[4] + (size_t)j * 384; const float* gkv = p->in[5] + (size_t)j * 256;
    const float* sgq = p->in[10] + (size_t)j * 128; const float* sgk = p->in[11] + (size_t)j * 128;
    const float inv = exp2f(-(float)(2 * lane) * (13.287712379549449f / 128.f));
    const float gq1 = sgq[lane], gq2 = sgq[lane + 64], gk1 = sgk[lane], gk2 = sgk[lane + 64];
    for (int lr0 = gw * 2; lr0 < R; lr0 += nw * 2) {
        u32x4 vq[2], vkv[2]; float x1[2][10], x2[2][10];
#pragma unroll
        for (int k = 0; k < 2; ++k) { const bf16_t* zr = zp + (size_t)(lr0 + k) * EINP;
            vq[k] = (u32x4){0u, 0u, 0u, 0u}; vkv[k] = (u32x4){0u, 0u, 0u, 0u};
            if (lane < 48) vq[k] = *(const u32x4*)(zr + C_CQ + lane * 8);
            if (lane < 32) vkv[k] = *(const u32x4*)(zr + C_CKV + lane * 8);
#pragma unroll
            for (int hh = 0; hh < 10; ++hh) { const bf16_t* hp = zr + (hh < 8 ? C_QS + hh * 128 : C_KS + (hh - 8) * 128); x1[k][hh] = bf2f(hp[lane]); x2[k][hh] = bf2f(hp[lane + 64]); } }
#pragma unroll
        for (int k = 0; k < 2; ++k) { const int lr = lr0 + k, t = lr % T; bf16_t* zr = zp + (size_t)lr * EINP;
            { float ss = 0.f;
#pragma unroll
              for (int e = 0; e < 4; ++e) { const float a = bflo(vq[k][e]), b = bfhi(vq[k][e]); ss += a * a + b * b; }
              const float rstd = rsqrtf(wave_sum(ss) * (1.f / 384.f) + EPS);
              if (lane < 48) { u32x4 o;
#pragma unroll
                  for (int e = 0; e < 4; ++e) o[e] = cvt_pk_bf16(bflo(vq[k][e]) * rstd * gq[lane * 8 + 2 * e], bfhi(vq[k][e]) * rstd * gq[lane * 8 + 2 * e + 1]);
                  *(u32x4*)(cqn + (size_t)lr * 384 + lane * 8) = o; } }
            { float ss = 0.f;
#pragma unroll
              for (int e = 0; e < 4; ++e) { const float a = bflo(vkv[k][e]), b = bfhi(vkv[k][e]); ss += a * a + b * b; }
              const float rstd = rsqrtf(wave_sum(ss) * (1.f / 256.f) + EPS);
              if (lane < 32) { u32x4 o;
#pragma unroll
                  for (int e = 0; e < 4; ++e) o[e] = cvt_pk_bf16(bflo(vkv[k][e]) * rstd * gkv[lane * 8 + 2 * e], bfhi(vkv[k][e]) * rstd * gkv[lane * 8 + 2 * e + 1]);
                  *(u32x4*)(ckvn + (size_t)lr * 256 + lane * 8) = o; } }
            float sn, cs; sincosf((float)t * inv, &sn, &cs);
#pragma unroll
            for (int hh = 0; hh < 10; ++hh) {
                const float rstd = rsqrtf(wave_sum(x1[k][hh] * x1[k][hh] + x2[k][hh] * x2[k][hh]) * (1.f / 128.f) + EPS);
                const float y1 = x1[k][hh] * rstd * (hh < 8 ? gq1 : gk1), y2 = x2[k][hh] * rstd * (hh < 8 ? gq2 : gk2);
                x1[k][hh] = y1 * cs - y2 * sn; x2[k][hh] = y1 * sn + y2 * cs;
            }
#pragma unroll
            for (int hh = 0; hh < 10; ++hh) { bf16_t* hp = zr + (hh < 8 ? C_QS + hh * 128 : C_KS + (hh - 8) * 128); hp[lane] = f2bf(x1[k][hh]); hp[lane + 64] = f2bf(x2[k][hh]); } }
    }
}
__device__ __forceinline__ void phase_post_mla(KP p, int j, int g, int wv) {
    asm volatile("" : "+s"(p));
    const int tid = otid(wv), lane = tid & 63, gw = obid() * NWAVES + wv, nw = gridDim.x * NWAVES;
    const bf16_t* zp = (const bf16_t*)(p->ws + A_ZP); bf16_t* q = (bf16_t*)(p->ws + A_Q); bf16_t* kb = (bf16_t*)(p->ws + A_K);
    const float* gqn = p->in[8] + (size_t)j * 192; const float* gkn = p->in[9] + (size_t)j * 192;
    const float inv = exp2f(-(float)(2 * (lane & 31)) * (13.287712379549449f / 64.f));
    const float gq0 = gqn[2 * lane], gq1 = gqn[2 * lane + 1], gqr = gqn[128 + lane], gk0 = gkn[2 * lane], gk1 = gkn[2 * lane + 1], gkr = gkn[128 + lane];
    static_assert(R % 2 == 0, "two rows per wave step");
    for (int lr0 = gw * 2; lr0 < R; lr0 += nw * 2) {
        unsigned kn[2][8]; float pe[2], sn[2], cs[2];
#pragma unroll
        for (int k = 0; k < 2; ++k) { const int lr = lr0 + k; const bf16_t* krow = kb + (size_t)lr * 1536;
            pe[k] = bf2f(zp[(size_t)lr * EINP + C_KPE + lane]);
#pragma unroll
            for (int h = 0; h < 8; ++h) kn[k][h] = *(const unsigned*)(krow + h * 192 + 2 * lane); }
#pragma unroll
        for (int k = 0; k < 2; ++k) { const int lr = lr0 + k, t = lr % T; sincosf((float)t * inv, &sn[k], &cs[k]);
            bf16_t* krow = kb + (size_t)lr * 1536;
            const float pess = wave_sum(pe[k] * pe[k]);
#pragma unroll
            for (int h = 0; h < 8; ++h) {
                const float n0 = bflo(kn[k][h]), n1 = bfhi(kn[k][h]);
                const float rstd = rsqrtf((wave_sum(n0 * n0 + n1 * n1) + pess) * (1.f / 192.f) + EPS);
                kn[k][h] = cvt_pk_bf16(n0 * rstd * gk0, n1 * rstd * gk1);
                const float y = pe[k] * rstd * gkr; auto rr = __builtin_amdgcn_permlane32_swap(__float_as_uint(y), __float_as_uint(y), false, false);
                const float x1 = __uint_as_float(rr[0]), x2 = __uint_as_float(rr[1]);
                krow[h * 192 + 128 + lane] = f2bf(lane < 32 ? x1 * cs[k] - x2 * sn[k] : x1 * sn[k] + x2 * cs[k]);
            }
#pragma unroll
            for (int h = 0; h < 8; ++h) *(unsigned*)(krow + h * 192 + 2 * lane) = kn[k][h]; }
    }
}
__device__ __forceinline__ void phase_conv(KP p, int j, int wv) {
    asm volatile("" : "+s"(p));
    const bf16_t* u = (const bf16_t*)(p->ws + A_ZP); bf16_t* xc = (bf16_t*)(p->ws + A_XC);
    const float* cw = p->in[15] + (size_t)j * 4 * DI; const float* cb = p->in[16] + (size_t)j * DI;
    static_assert(T % 16 == 0 && R % 16 == 0, "conv strips");
    const int nthr = gridDim.x * NTHR, nst = ((R / 16) * (DI / 8) / nthr) * nthr;
    for (int task = obid() * NTHR + otid(wv); task < (R - (nst >> 8) * 16) * (DI / 8); task += nthr) {
        const int lr = (nst >> 8) * 16 + (task >> 8), c0 = (task & 255) * 8, t = lr % T;
        float acc[8];
#pragma unroll
        for (int e = 0; e < 8; ++e) acc[e] = cb[c0 + e];
#pragma unroll
        for (int tap = 0; tap < 4; ++tap) { const int tt = t + tap - 2;
            if (tt >= 0 && tt < T) { const u32x4 v = *(const u32x4*)(u + (size_t)(lr + tap - 2) * OIN + c0); const float* w = cw + tap * DI + c0;
#pragma unroll
                for (int e = 0; e < 4; ++e) { acc[2 * e] += bflo(v[e]) * w[2 * e]; acc[2 * e + 1] += bfhi(v[e]) * w[2 * e + 1]; } } }
        u32x4 o;
#pragma unroll
        for (int e = 0; e < 4; ++e) o[e] = cvt_pk_bf16(acc[2 * e], acc[2 * e + 1]);
        *(u32x4*)(xc + (size_t)lr * DI + c0) = o;
    }
    for (int task = obid() * NTHR + otid(wv); task < nst; task += nthr) {
        const int c0 = (task & 255) * 8, lr0 = (task >> 8) * 16, t0 = lr0 % T;
        float w[4][8], bias[8];
#pragma unroll
        for (int e = 0; e < 8; ++e) { bias[e] = cb[c0 + e];
#pragma unroll
            for (int tap = 0; tap < 4; ++tap) w[tap][e] = cw[tap * DI + c0 + e]; }
        u32x4 rows[19];
#pragma unroll
        for (int k = 0; k < 19; ++k) { const int tt = t0 + k - 2;
            rows[k] = (tt >= 0 && tt < T) ? *(const u32x4*)(u + (size_t)(lr0 + k - 2) * OIN + c0) : (u32x4){0u, 0u, 0u, 0u}; }
#pragma unroll
        for (int r = 0; r < 16; ++r) { float acc[8];
#pragma unroll
            for (int e = 0; e < 8; ++e) acc[e] = bias[e];
#pragma unroll
            for (int tap = 0; tap < 4; ++tap) { const u32x4 v = rows[r + tap];
#pragma unroll
                for (int e = 0; e < 4; ++e) { acc[2 * e] += bflo(v[e]) * w[tap][2 * e]; acc[2 * e + 1] += bfhi(v[e]) * w[tap][2 * e + 1]; } }
            u32x4 o;
#pragma unroll
            for (int e = 0; e < 4; ++e) o[e] = cvt_pk_bf16(acc[2 * e], acc[2 * e + 1]);
            *(u32x4*)(xc + (size_t)(lr0 + r) * DI + c0) = o; }
    }
}
__device__ __forceinline__ int chunk_start(int k) { return (k * T) / NCH; }
__device__ __forceinline__ void phase_scan_a(KP p, int d, int wv) {
    asm volatile("" : "+s"(p));
    const bf16_t* LA = (const bf16_t*)(p->ws + A_LA); const bf16_t* BB = (const bf16_t*)(p->ws + A_BB);
    float* CP = (float*)(p->ws + WS_CARP); float* CH = (float*)(p->ws + WS_CARH);
    for (int task = obid() * NTHR + otid(wv); task < GB * NCH * (DI / 4); task += gridDim.x * NTHR) {
        const int cp = task & 511, ck = (task >> 9) & (NCH - 1), bl = task / (512 * NCH);
        const int t0 = chunk_start(ck), t1 = chunk_start(ck + 1), n = t1 - t0;
        const size_t base = (size_t)bl * T * DI + 4 * cp;
        float s[4] = {0.f, 0.f, 0.f, 0.f}, h[4] = {0.f, 0.f, 0.f, 0.f};
        for (int i0 = 0; i0 < n; i0 += 16) { const int nb = n - i0;
            u32x2 la[16], bb[16];
#pragma unroll
            for (int k = 0; k < 16; ++k) if (k < nb) { const int t = d == 0 ? t0 + i0 + k : t1 - 1 - i0 - k;
                la[k] = *(const u32x2*)(LA + base + (size_t)t * DI); bb[k] = *(const u32x2*)(BB + base + (size_t)t * DI); }
#pragma unroll
            for (int k = 0; k < 16; ++k) if (k < nb) {
                const float l0 = h2lo(la[k].x), l1 = h2hi(la[k].x), l2 = h2lo(la[k].y), l3 = h2hi(la[k].y);
                h[0] = __builtin_amdgcn_exp2f(l0) * h[0] + bflo(bb[k].x); h[1] = __builtin_amdgcn_exp2f(l1) * h[1] + bfhi(bb[k].x);
                h[2] = __builtin_amdgcn_exp2f(l2) * h[2] + bflo(bb[k].y); h[3] = __builtin_amdgcn_exp2f(l3) * h[3] + bfhi(bb[k].y);
                s[0] += l0; s[1] += l1; s[2] += l2; s[3] += l3; } }
        const size_t ci = ((size_t)bl * NCH + ck) * DI + 4 * cp;
        *(f32x4*)(CP + ci) = (f32x4){__builtin_amdgcn_exp2f(s[0]), __builtin_amdgcn_exp2f(s[1]), __builtin_amdgcn_exp2f(s[2]), __builtin_amdgcn_exp2f(s[3])};
        *(f32x4*)(CH + ci) = (f32x4){h[0], h[1], h[2], h[3]};
    }
}
__device__ __forceinline__ void phase_scan_b(KP p, int d, int wv) {
    asm volatile("" : "+s"(p));
    const bf16_t* LA = (const bf16_t*)(p->ws + A_LA); const bf16_t* BB = (const bf16_t*)(p->ws + A_BB);
    bf16_t* zp = (bf16_t*)(p->ws + A_ZP);
    const float* CP = (const float*)(p->ws + WS_CARP); const float* CH = (const float*)(p->ws + WS_CARH);
    for (int task = obid() * NTHR + otid(wv); task < GB * NCH * (DI / 4); task += gridDim.x * NTHR) {
        const int cp = task & 511, ck = (task >> 9) & (NCH - 1), bl = task / (512 * NCH);
        const int t0 = chunk_start(ck), t1 = chunk_start(ck + 1), n = t1 - t0;
        f32x4 h = {0.f, 0.f, 0.f, 0.f};
        { const int nprev = d == 0 ? ck : NCH - 1 - ck;
          for (int i = 0; i < nprev; ++i) { const int c = d == 0 ? i : NCH - 1 - i; const size_t ci = ((size_t)bl * NCH + c) * DI + 4 * cp;
              const f32x4 P = *(const f32x4*)(CP + ci), H = *(const f32x4*)(CH + ci); h = P * h + H; } }
        const size_t base = (size_t)bl * T * DI + 4 * cp; const size_t ybase = (size_t)bl * T * OIN + 4 * cp;
        for (int i0 = 0; i0 < n; i0 += 16) { const int nb = n - i0;
            u32x2 la[16], bb[16], yv[16], gv[16];
#pragma unroll
            for (int k = 0; k < 16; ++k) if (k < nb) { const int t = d == 0 ? t0 + i0 + k : t1 - 1 - i0 - k;
                la[k] = __builtin_nontemporal_load((const u32x2*)(LA + base + (size_t)t * DI)); bb[k] = __builtin_nontemporal_load((const u32x2*)(BB + base + (size_t)t * DI));
                if (d != 0) { yv[k] = *(const u32x2*)(zp + ybase + (size_t)t * OIN); gv[k] = __builtin_nontemporal_load((const u32x2*)(zp + ybase + (size_t)t * OIN + DI)); } }
#pragma unroll
            for (int k = 0; k < 16; ++k) if (k < nb) { const int t = d == 0 ? t0 + i0 + k : t1 - 1 - i0 - k;
                h[0] = __builtin_amdgcn_exp2f(h2lo(la[k].x)) * h[0] + bflo(bb[k].x); h[1] = __builtin_amdgcn_exp2f(h2hi(la[k].x)) * h[1] + bfhi(bb[k].x);
                h[2] = __builtin_amdgcn_exp2f(h2lo(la[k].y)) * h[2] + bflo(bb[k].y); h[3] = __builtin_amdgcn_exp2f(h2hi(la[k].y)) * h[3] + bfhi(bb[k].y);
                u32x2 o;
                if (d == 0) { o.x = cvt_pk_bf16(h[0], h[1]); o.y = cvt_pk_bf16(h[2], h[3]); }
                else { o.x = cvt_pk_bf16((bflo(yv[k].x) + h[0]) * siluf_(bflo(gv[k].x)), (bfhi(yv[k].x) + h[1]) * siluf_(bfhi(gv[k].x)));
                       o.y = cvt_pk_bf16((bflo(yv[k].y) + h[2]) * siluf_(bflo(gv[k].y)), (bfhi(yv[k].y) + h[3]) * siluf_(bfhi(gv[k].y))); }
                *(u32x2*)(zp + ybase + (size_t)t * OIN) = o; } }
    }
}

__device__ __forceinline__ void phase_attn(KP p, int j, char* lds, int wv) {
    asm volatile("" : "+s"(p));
    const int G = gridDim.x, bx = obid(), vcu = (G % 8 == 0) ? (bx % 8) * (G / 8) + bx / 8 : bx;
    bf16_t* zp = (bf16_t*)(p->ws + A_ZP); const bf16_t* q = (const bf16_t*)(p->ws + A_Q); const bf16_t* kb = (const bf16_t*)(p->ws + A_K); const bf16_t* vb = (const bf16_t*)(p->ws + A_V);
    constexpr int NFULL = GB * 8 * 16, NTAIL = GB * 8, NSWA = GB * 8 * 17;
#ifndef ATT_REP
#define ATT_REP 1
#endif
    const int nfl = (NFULL - vcu + G - 1) / G;
    const bool split = G > NTAIL; const int nsw = split ? G - NTAIL : G, sb = split ? vcu - NTAIL : vcu;
    const int ntl = split ? (vcu < NTAIL ? 1 : 0) : (NTAIL - vcu + G - 1) / G;
    const int nsv = sb >= 0 ? (NSWA - sb + nsw - 1) / nsw : 0;
    for (int rp = 0; rp < ATT_REP; ++rp)
    for (int it = 0; it < nfl + ntl + nsv; ++it) {
        const bool dostore = rp == ATT_REP - 1;
        if (it < nfl + ntl) {
            int bh, qb; if (it < nfl) { const int u = vcu + it * G; bh = u >> 4; qb = u & 15; } else { bh = vcu + (it - nfl) * G; qb = 16; }
            const int bl = bh >> 3, h = bh & 7; const size_t r0 = (size_t)bl * T;
            att::attn_unit<192, 1536, 1536, 1024, false>(q + r0 * 1536 + h * 192, kb + r0 * 1536 + h * 192, vb + r0 * 1024 + h * 128,
                                                          zp + r0 * EINP + C_GATE + h * 128, qb * 256, 66, 0, -1e30f, 0.f, lds, (LAS unsigned char*)lds, wv, dostore, p->in[8] + (size_t)j * 192);
        } else {
            const int v = sb + (it - nfl - ntl) * nsw, bh = v / 17, qb = v - bh * 17, bl = bh >> 3, h = bh & 7, kvh = h >> 2; const size_t r0 = (size_t)bl * T;
            const int i0 = qb * 256, t64 = i0 / 64, tfirst = t64 >= 2 ? t64 - 2 : 0, tlast = t64 + 6 < 65 ? t64 + 6 : 65;
            int n = tlast - tfirst + (tfirst > 0 ? 1 : 0); n = (n + 1) & ~1;
            const float sink = p->in[12][j * 8 + h];
            att::attn_unit<128, EINP, EINP, EINP, true>(zp + r0 * EINP + C_QS + h * 128, zp + r0 * EINP + C_KS + kvh * 128, zp + r0 * EINP + C_VS + kvh * 128,
                                                         zp + r0 * EINP + C_GATE + 1024 + h * 128, i0, n, tfirst, sink * 11.313708498984761f, 1.f, lds, (LAS unsigned char*)lds, wv, dostore, nullptr);
        }
    }
}

#define XB_TMO      128
#define XB_XCNT(j)  (256  + 64 * (j))
#define XB_XSUB(j)  (1280 + 64 * (j))
#define XB_XGEN(j)  (2304 + 64 * (j))
#define XB_TOP      3328
#define XB_TOPGEN   3392
#define XCD_BAR_WORDS 3456
#define XB_SPIN_CAP (1u << 20)
__device__ __forceinline__ unsigned xb_ld(unsigned* p)              { return __hip_atomic_load(p, __ATOMIC_RELAXED, __HIP_MEMORY_SCOPE_AGENT); }
__device__ __forceinline__ unsigned xb_add(unsigned* p, unsigned v) { return __hip_atomic_fetch_add(p, v, __ATOMIC_RELAXED, __HIP_MEMORY_SCOPE_AGENT); }
__device__ __forceinline__ unsigned xb_xcc_id() { return (unsigned)__builtin_amdgcn_s_getreg((3 << 11) | 20) & 0xFu; }
#define XB_SPIN(cond, bar) do { unsigned _sp = 0; while (cond) { __builtin_amdgcn_s_sleep(1); \
    if ((++_sp & 255u) == 0u) { if (xb_ld(&(bar)[XB_TMO])) break; if (_sp > XB_SPIN_CAP) { atomicAdd(&(bar)[XB_TMO], 1u); break; } } } } while (0)
__device__ __forceinline__ void xcd_barrier_complete(unsigned* bar, unsigned x, unsigned G, unsigned& nloc, unsigned& nx) {
    unsigned sum, cnt, mine, sp = 0u;
    for (;;) {
        sum = 0u; cnt = 0u; mine = 0u;
#pragma unroll
        for (unsigned j = 0; j < 16; ++j) { const unsigned c = xb_ld(&bar[XB_XCNT(j)]); sum += c; cnt += (c > 0u) ? 1u : 0u; mine = (j == x) ? c : mine; }
        if (sum == G) break;
        __builtin_amdgcn_s_sleep(1);
        if ((++sp & 255u) == 0u) { if (xb_ld(&bar[XB_TMO])) break; if (sp > XB_SPIN_CAP) { atomicAdd(&bar[XB_TMO], 1u); break; } }
    }
    nloc = mine > 0u ? mine : 1u; nx = cnt > 0u ? cnt : 1u;
}
__device__ __forceinline__ void grid_bar(unsigned* bar, unsigned x, volatile LAS unsigned* st, unsigned G, int wv, int lane) {
    asm volatile("s_waitcnt vmcnt(0)" ::: "memory");
    __syncthreads();
    if (wv == 0 && lane == 0) {
        __builtin_amdgcn_s_waitcnt(0);
        unsigned nloc = st[0], nx = st[1];
        if (nloc == 0u) { xcd_barrier_complete(bar, x, G, nloc, nx); st[0] = nloc; st[1] = nx; }
        const unsigned old = xb_add(&bar[XB_XSUB(x)], 1u);
        const unsigned gen = old / nloc;
        if (old + 1u == (gen + 1u) * nloc) {
            __builtin_amdgcn_fence(__ATOMIC_RELEASE, "agent");
            asm volatile("s_waitcnt vmcnt(0)" ::: "memory");
            const unsigned og = xb_add(&bar[XB_TOP], 1u);
            const unsigned tg = og / nx;
            if (og + 1u == (tg + 1u) * nx) xb_add(&bar[XB_TOPGEN], 1u);
            else XB_SPIN(xb_ld(&bar[XB_TOPGEN]) == tg, bar);
            __builtin_amdgcn_fence(__ATOMIC_ACQUIRE, "agent");
            xb_add(&bar[XB_XGEN(x)], 1u);
            asm volatile("s_waitcnt vmcnt(0)" ::: "memory");
        } else {
            XB_SPIN(xb_ld(&bar[XB_XGEN(x)]) == gen, bar);
            __builtin_amdgcn_fence(__ATOMIC_ACQUIRE, "agent");
            asm volatile("s_waitcnt vmcnt(0)" ::: "memory");
        }
    }
    __syncthreads();
}

__global__ void __launch_bounds__(NTHR, 2) hybrid_fwd(Params p_unused) {
    extern __shared__ __attribute__((aligned(16))) unsigned char lds[];
    const int wv = __builtin_amdgcn_readfirstlane((int)(threadIdx.x >> 6));
    const unsigned G = gridDim.x;
    LAS unsigned char* ldsl = (LAS unsigned char*)lds;
    KP kp = (KP)__builtin_amdgcn_kernarg_segment_ptr();
    unsigned* barw = (unsigned*)(kp->ws + WS_BAR);
    volatile LAS unsigned* bst = (volatile LAS unsigned*)(ldsl + 131072 + 64);
    const unsigned xcc = xb_xcc_id();
    if (threadIdx.x == 0) { bst[0] = 0u; bst[1] = 0u; (void)xb_add(&barw[XB_XCNT(xcc)], 1u); }
    __syncthreads();
#define GBAR() do { grid_bar(barw, xcc, bst, G, wv, olane()); } while (0)
    phase_weights(kp, (char*)lds, wv);
    phase_norm(kp, 0, 0, wv);
    if (gridDim.y == 0x7fffffffu) cg::this_grid().sync();
    GBAR();
    for (int g = 0; g < NG; ++g) {
        for (int layer = 0; layer < 4; ++layer) {
            const int j = layer >> 1, bx = obid();
            if (layer != 0) { phase_norm(kp, layer, g, wv); GBAR(); }
            KP p = kp; asm volatile("" : "+s"(p));
            unsigned char* ws = p->ws;
            if ((layer & 1) == 0) {
                { pg8::Gemm gm{(const bf16_t*)(ws + A_Z), (const bf16_t*)(ws + WS_WINE) + (size_t)j * EINP * DM}; pg8::StaticOrder S; S.init(RP, EINP, G, bx);
                  pg8::EpiStore E{(bf16_t*)(ws + A_ZP), EINP};
                  pg8::gemm_phase<DM, DM, DM, 0, pg8::EpiStore, pg8::StaticOrder, false, true>(ldsl, gm, S, E, wv); }
                GBAR();
                phase_prep_even(kp, j, g, wv);
                GBAR();
                { pg8::Gemm gm{(const bf16_t*)(ws + A_CQN), (const bf16_t*)(ws + WS_WUQ) + (size_t)j * 1536 * 384}; pg8::StaticOrder S; S.init(RP, 1536, G, bx);
                  pg8::EpiStore E{(bf16_t*)(ws + A_Q), 1536};
                  pg8::gemm_phase<384, 384, 384, 0, pg8::EpiStore, pg8::StaticOrder, true, true>(ldsl, gm, S, E, wv); }
                { pg8::Gemm gm{(const bf16_t*)(ws + A_CKVN), (const bf16_t*)(ws + WS_WUKV) + (size_t)j * 2048 * 256}; pg8::StaticOrder S; S.init(RP, 2048, G, (int)G - 1 - bx);
                  pg8::EpiKV E{(bf16_t*)(ws + A_K), (bf16_t*)(ws + A_V)};
                  pg8::gemm_phase<256, 256, 256, 0, pg8::EpiKV, pg8::StaticOrder, true, true>(ldsl, gm, S, E, wv); }
                GBAR();
                phase_post_mla(kp, j, g, wv);
                GBAR();
                phase_attn(kp, j, (char*)lds, wv);
                GBAR();
                { pg8::Gemm gm{(const bf16_t*)(ws + A_ZP) + C_GATE, (const bf16_t*)(ws + WS_WOUTE) + (size_t)j * DM * DI}; pg8::TailOrder S; S.init(RP, DM, G, bx);
                  pg8::EpiRes E{p->in[0], p->in[1], p->out, (float*)(ws + WS_HMETA), layer, g};
                  pg8::gemm_phase<EINP, DI, DI, 0, pg8::EpiRes, pg8::TailOrder, true, true, RP / 256 - 1>(ldsl, gm, S, E, wv); }
                GBAR();
            } else {
                { pg8::Gemm gm{(const bf16_t*)(ws + A_Z), (const bf16_t*)(ws + WS_WINO) + (size_t)j * OIN * DM}; pg8::StaticOrder S; S.init(RP, OIN, G, bx);
                  pg8::EpiStore E{(bf16_t*)(ws + A_ZP), OIN};
                  pg8::gemm_phase<DM, DM, DM, 0, pg8::EpiStore, pg8::StaticOrder, false, true>(ldsl, gm, S, E, wv); }
                GBAR();
                phase_conv(kp, j, wv);
                GBAR();
                for (int d = 0; d < 2; ++d) {
                    { pg8::Gemm gm{(const bf16_t*)(ws + A_XC), (const bf16_t*)(ws + WS_WG) + (size_t)(j * 2 + d) * 16 * 256 * 128}; pg8::TailOrder S; S.init(RP, 16 * 256, G, bx);
                      pg8::EpiGate E{(const bf16_t*)(ws + A_XC), (bf16_t*)(ws + A_LA), (bf16_t*)(ws + A_BB),
                                     p->in[18] + (size_t)(j * 2 + d) * DI, p->in[20] + (size_t)(j * 2 + d) * DI, (const float*)(ws + WS_SP) + (size_t)(j * 2 + d) * DI};
                      pg8::gemm_phase<DI, 128, 128, 128, pg8::EpiGate, pg8::TailOrder, true, true>(ldsl, gm, S, E, wv); }
                    GBAR();
                    phase_scan_a(kp, d, wv);
                    GBAR();
                    phase_scan_b(kp, d, wv);
                    GBAR();
                }
                { pg8::Gemm gm{(const bf16_t*)(ws + A_ZP), (const bf16_t*)(ws + WS_WOUTO) + (size_t)j * DM * DI}; pg8::TailOrder S; S.init(RP, DM, G, bx);
                  pg8::EpiRes E{p->in[0], p->in[1], p->out, (float*)(ws + WS_HMETA), layer, g};
                  pg8::gemm_phase<OIN, DI, DI, 0, pg8::EpiRes, pg8::TailOrder, true, true, RP / 256 - 1>(ldsl, gm, S, E, wv); }
                if (layer == 3 && g + 1 < NG) phase_norm(kp, 0, g + 1, wv);
                GBAR();
            }
        }
    }
#undef GBAR
}

extern "C" void kernel_launch(void* const* d_in, const int* in_sizes, int n_in, void* d_out, int out_size, void* d_ws, size_t ws_size, hipStream_t stream) {
    static int grid = 0;
    if (grid == 0) {
        if (n_in != 23 || out_size != NBATCH * SEQ * DM || ws_size < WS_NEED) { fprintf(stderr, "kernel_launch: unexpected shapes (n_in %d out %d ws %zu need %zu)\n", n_in, out_size, ws_size, (size_t)WS_NEED); grid = -1; return; }
        int dev = 0, cus = 0, per_cu = 0;
        hipGetDevice(&dev); hipDeviceGetAttribute(&cus, hipDeviceAttributeMultiprocessorCount, dev);
        if (hipFuncSetAttribute((const void*)hybrid_fwd, hipFuncAttributeMaxDynamicSharedMemorySize, LDS_BYTES) != hipSuccess) { fprintf(stderr, "kernel_launch: hipFuncSetAttribute failed\n"); grid = -1; return; }
        if (hipOccupancyMaxActiveBlocksPerMultiprocessor(&per_cu, (const void*)hybrid_fwd, NTHR, LDS_BYTES) != hipSuccess || per_cu < 1) { fprintf(stderr, "kernel_launch: occupancy query failed (%d)\n", per_cu); per_cu = 1; (void)hipGetLastError(); }
        grid = cus * per_cu;
    }
    if (grid < 0) return;
    Params p{};
    for (int i = 0; i < 23; ++i) p.in[i] = (const float*)d_in[i];
    p.out = (float*)d_out; p.ws = (unsigned char*)d_ws;
    (void)hipMemsetAsync((char*)d_ws + WS_BAR, 0, 16384, stream);
    void* args[] = {&p};
    hipError_t e = hipLaunchCooperativeKernel((const void*)hybrid_fwd, dim3(grid), dim3(NTHR), args, LDS_BYTES, stream);
    if (e != hipSuccess) fprintf(stderr, "cooperative launch failed: %s (grid %d)\n", hipGetErrorString(e), grid);
}
```
